# Optimizing an MI355X kernel written in HIP

```python
import jax
import jax.numpy as jnp
from jax import lax
import numpy as np

D_MODEL = 2048
BATCH = 8
SEQ = 2048
DEPTH = 2
DEC_BATCH = 128
DEC_SEQ = 1
PAST_LEN = 8192
PAGE_SIZE = 128

PLE_DIM = 256
D_MIX = D_MODEL
A_DK = 128
A_DV = 128
A_HEADS = (D_MIX // 2) // A_DV
A_WIDTH = A_HEADS * A_DV
HGRN_CHUNK = 64
B_DH = 64
B_HEADS = (D_MIX // 4) // B_DH
B_KV_HEADS = max(1, B_HEADS // 4)
B_GROUP = B_HEADS // B_KV_HEADS
B_WIDTH = B_HEADS * B_DH
WINDOW = 128
C_DG = 128
C_GROUPS = (D_MIX - A_WIDTH - B_WIDTH) // C_DG
C_WIDTH = C_GROUPS * C_DG
C_CHUNK = 128
D_FF = 256 * ((8 * D_MODEL // 3 + 255) // 256)
CONV_W = 3
EPS = 1e-6
D_IN = 4 * A_WIDTH + B_WIDTH + 2 * B_KV_HEADS * B_DH + 2 * C_WIDTH
SPLITS = (4 * A_WIDTH, 4 * A_WIDTH + B_WIDTH, 4 * A_WIDTH + B_WIDTH + B_KV_HEADS * B_DH, 4 * A_WIDTH + B_WIDTH + 2 * B_KV_HEADS * B_DH)

kernel_name = 'hymba_hgrn2_swa_gmlp_convffn_step'


def rms_norm(x, g):
    xf = x.astype(jnp.float32)
    y = xf * lax.rsqrt(jnp.mean(xf * xf, -1, keepdims=True) + EPS)
    return (y * g.astype(jnp.float32)).astype(x.dtype)


def layer_norm(x, g, b):
    xf = x.astype(jnp.float32)
    xc = xf - jnp.mean(xf, -1, keepdims=True)
    y = xc * lax.rsqrt(jnp.mean(xc * xc, -1, keepdims=True) + EPS)
    return (y * g.astype(jnp.float32) + b.astype(jnp.float32)).astype(x.dtype)


def hgrn2_lower_bounds(lb_logits):
    sm = jax.nn.softmax(lb_logits.astype(jnp.float32), axis=0)
    cs = jnp.cumsum(sm, axis=0)
    return cs - cs[0:1]


def hgrn2_chunked(q, log_f, k, v, s0):
    bsz, t, h, dk = q.shape
    dv = v.shape[-1]
    c = HGRN_CHUNK if t >= HGRN_CHUNK else t
    n = -(-t // c)
    pad = n * c - t

    def prep(a):
        a = jnp.pad(a, ((0, 0), (0, pad), (0, 0), (0, 0)))
        return a.reshape(bsz, n, c, h, a.shape[-1]).transpose(1, 0, 3, 2, 4)

    causal = jnp.tril(jnp.ones((c, c), bool))[:, :, None]

    def step(s, blk):
        qc, lfc, kc, vc = blk
        b = jnp.cumsum(lfc, axis=2)
        o_inter = jnp.einsum('bhtk,bhkv->bhtv', qc * jnp.exp(b), s)
        diff = b[:, :, :, None, :] - b[:, :, None, :, :]
        decay = jnp.exp(jnp.where(causal, diff, -jnp.inf))
        scores = jnp.einsum('bhtk,bhsk,bhtsk->bhts', qc, kc, decay)
        o_intra = jnp.einsum('bhts,bhsv->bhtv', scores, vc)
        b_last = b[:, :, -1:, :]
        s_new = jnp.exp(b_last[:, :, 0, :])[..., None] * s + jnp.einsum('bhsk,bhsv->bhkv', kc * jnp.exp(b_last - b), vc)
        return s_new, o_inter + o_intra

    s_fin, o = lax.scan(step, s0, (prep(q), prep(log_f), prep(k), prep(v)))
    o = o.transpose(1, 0, 3, 2, 4).reshape(bsz, n * c, h, dv)[:, :t]
    return o, s_fin


def mixer_hgrn2(za, lb, norm_g, s0):
    bsz, t, _ = za.shape
    zq, zf, zi, zg = jnp.split(za, 4, axis=-1)

    def heads(a):
        return a.reshape(bsz, t, A_HEADS, -1).astype(jnp.float32)

    q = jax.nn.silu(heads(zq))
    lbh = lb.reshape(A_HEADS, A_DK)
    log_f = jnp.logaddexp(jnp.log(lbh), jnp.log1p(-lbh) + jax.nn.log_sigmoid(heads(zf)))
    k = -jnp.expm1(log_f)
    v = heads(zi)
    o, s_fin = hgrn2_chunked(q, log_f, k, v, s0.astype(jnp.float32))
    o = rms_norm(o, norm_g) * jax.nn.silu(heads(zg))
    return o.reshape(bsz, t, A_WIDTH).astype(za.dtype), s_fin.astype(za.dtype)


def sink_attend(q, k, v, mask, sink):
    s = jnp.einsum('bnhgqd,bnhkd->bnhgqk', q.astype(jnp.float32), k.astype(jnp.float32)) * (B_DH ** -0.5)
    s = jnp.where(mask, s, -jnp.inf)
    sink_b = sink.astype(jnp.float32).reshape(B_KV_HEADS, B_GROUP)[:, :, None, None]
    m = jnp.maximum(jnp.max(s, -1, keepdims=True), sink_b)
    p = jnp.exp(s - m)
    denom = jnp.sum(p, -1, keepdims=True) + jnp.exp(sink_b - m)
    return jnp.einsum('bnhgqk,bnhkd->bnhgqd', p, v.astype(jnp.float32)) / denom


def swa_prompt(q, k, v, sink):
    bsz, t = q.shape[:2]
    nb = t // WINDOW
    qb = q.reshape(bsz, nb, WINDOW, B_KV_HEADS, B_GROUP, B_DH).transpose(0, 1, 3, 4, 2, 5)

    def blocks(a):
        a = a.reshape(bsz, nb, WINDOW, B_KV_HEADS, B_DH).transpose(0, 1, 3, 2, 4)
        prev = jnp.pad(a, ((0, 0), (1, 0), (0, 0), (0, 0), (0, 0)))[:, :-1]
        return jnp.concatenate([prev, a], axis=3)

    qi = jnp.arange(WINDOW)[:, None]
    kj = jnp.arange(2 * WINDOW)[None, :]
    band = (kj > qi) & (kj <= qi + WINDOW)
    not_first = jnp.arange(nb)[:, None, None] > 0
    mask = (band[None] & (not_first | (kj >= WINDOW)[None]))[:, None, None]
    o = sink_attend(qb, blocks(k), blocks(v), mask, sink)
    return o.transpose(0, 1, 4, 2, 3, 5).reshape(bsz, t, B_WIDTH)


def swa_decode(q, k, v, ck, cv, sink):
    bsz, t = q.shape[:2]
    kk = jnp.concatenate([ck.astype(k.dtype), k], axis=1)
    vv = jnp.concatenate([cv.astype(v.dtype), v], axis=1)
    qb = q.reshape(bsz, t, B_KV_HEADS, B_GROUP, B_DH).transpose(0, 2, 3, 1, 4)[:, None]
    kb = kk.transpose(0, 2, 1, 3)[:, None]
    vb = vv.transpose(0, 2, 1, 3)[:, None]
    qi = jnp.arange(t)[:, None]
    kj = jnp.arange(WINDOW + t)[None, :]
    mask = ((kj > qi) & (kj <= qi + WINDOW))[None, None, None]
    o = sink_attend(qb, kb, vb, mask, sink)
    o = o[:, 0].transpose(0, 3, 1, 2, 4).reshape(bsz, t, B_WIDTH)
    return o, kk[:, -WINDOW:], vv[:, -WINDOW:]


def chunk_mix(v, ws, bs):
    bsz, t = v.shape[:2]
    n = -(-t // C_CHUNK)
    pad = n * C_CHUNK - t
    vp = jnp.pad(v, ((0, 0), (0, pad), (0, 0), (0, 0))).reshape(bsz, n, C_CHUNK, C_GROUPS, C_DG)
    w = jnp.where(jnp.tril(jnp.ones((C_CHUNK, C_CHUNK), bool)), ws, 0.0).astype(v.dtype)
    mixed = jnp.einsum('gpq,bnqgc->bnpgc', w, vp) + bs.T[:, :, None].astype(v.dtype)
    return mixed.reshape(bsz, n * C_CHUNK, C_GROUPS, C_DG)[:, :t]


def mixer_gmlp(zc, ln_g, ln_b, ws, bs):
    bsz, t, _ = zc.shape
    u, vr = jnp.split(jax.nn.gelu(zc), 2, axis=-1)
    vn = layer_norm(vr, ln_g, ln_b).reshape(bsz, t, C_GROUPS, C_DG)
    out = u * chunk_mix(vn, ws, bs).reshape(bsz, t, C_WIDTH)
    return out, vn


def conv_ffn(h, prev, w_up, conv_w, conv_b, w_down):
    up = h @ w_up
    t = up.shape[1]
    xp = jnp.concatenate([prev.astype(up.dtype), up], axis=1)
    conv = conv_b + conv_w[0] * xp[:, 0:t]
    for j in range(1, CONV_W):
        conv = conv + conv_w[j] * xp[:, j:j + t]
    gate, val = jnp.split(conv, 2, axis=-1)
    return (jax.nn.silu(gate) * val) @ w_down, xp[:, -(CONV_W - 1):]


def trunk_layer(x, p, lb, st_hgrn, st_k, st_v, st_conv, w, decode):
    bsz, t, _ = x.shape
    h = rms_norm(x, w['norm1_g'])
    z = h @ w['w_in']
    za, zq, zk, zv, zc = jnp.split(z, SPLITS, axis=-1)
    o_a, hgrn_new = mixer_hgrn2(za, lb, w['hgrn_norm_g'], st_hgrn)
    q = rms_norm(zq.reshape(bsz, t, B_HEADS, B_DH), w['q_norm_g'])
    k = rms_norm(zk.reshape(bsz, t, B_KV_HEADS, B_DH), w['k_norm_g'])
    v = zv.reshape(bsz, t, B_KV_HEADS, B_DH)
    if decode:
        o_b, k_new, v_new = swa_decode(q, k, v, st_k, st_v, w['swa_sinks'])
    else:
        o_b = swa_prompt(q, k, v, w['swa_sinks'])
        k_new, v_new = k[:, -WINDOW:], v[:, -WINDOW:]
    o_c, c_rows = mixer_gmlp(zc, w['gmlp_ln_g'], w['gmlp_ln_b'], w['gmlp_ws'], w['gmlp_bs'])
    mix = jnp.concatenate([o_a, o_b.astype(x.dtype), o_c.astype(x.dtype)], axis=-1)
    x = x + mix @ w['w_out']
    f, conv_new = conv_ffn(rms_norm(x, w['norm2_g']), st_conv, w['w_up'], w['conv_w'], w['conv_b'], w['w_down'])
    x = x + f
    x = x + jax.nn.sigmoid(rms_norm(x, w['ple_norm_g']) @ w['w_ple_gate']) * (p @ w['w_ple_proj'])
    return x, hgrn_new, k_new, v_new, c_rows, conv_new


def setup_inputs(seed: int = 0) -> dict:
    key = jax.random.key(seed)
    ks = jax.random.split(key, 28)

    def nrm(k, shape, scale=1.0):
        return scale * jax.random.normal(k, shape, jnp.float32)

    return {
        'x_prompt': nrm(ks[0], (BATCH, SEQ, D_MODEL)),
        'x_sample': nrm(ks[1], (DEC_BATCH, DEC_SEQ, D_MODEL)),
        'state_hgrn': nrm(ks[2], (DEPTH, DEC_BATCH, A_HEADS, A_DK, A_DV), 0.5),
        'cache_swa_k': nrm(ks[3], (DEPTH, DEC_BATCH, WINDOW, B_KV_HEADS, B_DH)),
        'cache_swa_v': nrm(ks[4], (DEPTH, DEC_BATCH, WINDOW, B_KV_HEADS, B_DH)),
        'state_ffn_conv': nrm(ks[5], (DEPTH, DEC_BATCH, CONV_W - 1, 2 * D_FF)),
        'p_prompt': nrm(ks[6], (DEPTH, BATCH, SEQ, PLE_DIM)),
        'p_sample': nrm(ks[7], (DEPTH, DEC_BATCH, DEC_SEQ, PLE_DIM)),
        'norm1_g': 1.0 + nrm(ks[8], (DEPTH, D_MODEL), 0.1),
        'w_in': nrm(ks[9], (DEPTH, D_MODEL, D_IN), D_MODEL ** -0.5),
        'hgrn_lb_logits': nrm(ks[10], (DEPTH, A_HEADS * A_DK)),
        'hgrn_norm_g': 1.0 + nrm(ks[11], (DEPTH, A_DV), 0.1),
        'q_norm_g': 1.0 + nrm(ks[12], (DEPTH, B_DH), 0.1),
        'k_norm_g': 1.0 + nrm(ks[13], (DEPTH, B_DH), 0.1),
        'swa_sinks': nrm(ks[14], (DEPTH, B_HEADS), 0.5),
        'gmlp_ln_g': 1.0 + nrm(ks[15], (DEPTH, C_WIDTH), 0.1),
        'gmlp_ln_b': nrm(ks[16], (DEPTH, C_WIDTH), 0.02),
        'gmlp_ws': nrm(ks[17], (DEPTH, C_GROUPS, C_CHUNK, C_CHUNK), C_CHUNK ** -0.5),
        'gmlp_bs': 1.0 + nrm(ks[18], (DEPTH, C_GROUPS, C_CHUNK), 0.1),
        'w_out': nrm(ks[19], (DEPTH, D_MIX, D_MODEL), D_MIX ** -0.5),
        'norm2_g': 1.0 + nrm(ks[20], (DEPTH, D_MODEL), 0.1),
        'w_up': nrm(ks[21], (DEPTH, D_MODEL, 2 * D_FF), D_MODEL ** -0.5),
        'conv_w': nrm(ks[22], (DEPTH, CONV_W, 2 * D_FF), CONV_W ** -0.5),
        'conv_b': nrm(ks[23], (DEPTH, 2 * D_FF), 0.02),
        'w_down': nrm(ks[24], (DEPTH, D_FF, D_MODEL), D_FF ** -0.5),
        'ple_norm_g': 1.0 + nrm(ks[25], (DEPTH, D_MODEL), 0.1),
        'w_ple_gate': nrm(ks[26], (DEPTH, D_MODEL, D_MODEL), D_MODEL ** -0.5),
        'w_ple_proj': nrm(ks[27], (DEPTH, PLE_DIM, D_MODEL), PLE_DIM ** -0.5),
    }


def reference(x_prompt, x_sample, state_hgrn, cache_swa_k, cache_swa_v, state_ffn_conv, p_prompt, p_sample,
              norm1_g, w_in, hgrn_lb_logits, hgrn_norm_g, q_norm_g, k_norm_g, swa_sinks, gmlp_ln_g, gmlp_ln_b,
              gmlp_ws, gmlp_bs, w_out, norm2_g, w_up, conv_w, conv_b, w_down, ple_norm_g, w_ple_gate, w_ple_proj):
    lbs = hgrn2_lower_bounds(hgrn_lb_logits)
    xp, xs = x_prompt, x_sample
    hp, hs, kp, vp, ksm, vsm, gs, cp, cs = [], [], [], [], [], [], [], [], []
    for l in range(DEPTH):
        w = {
            'norm1_g': norm1_g[l], 'w_in': w_in[l], 'hgrn_norm_g': hgrn_norm_g[l],
            'q_norm_g': q_norm_g[l], 'k_norm_g': k_norm_g[l], 'swa_sinks': swa_sinks[l],
            'gmlp_ln_g': gmlp_ln_g[l], 'gmlp_ln_b': gmlp_ln_b[l], 'gmlp_ws': gmlp_ws[l], 'gmlp_bs': gmlp_bs[l],
            'w_out': w_out[l], 'norm2_g': norm2_g[l], 'w_up': w_up[l], 'conv_w': conv_w[l],
            'conv_b': conv_b[l], 'w_down': w_down[l], 'ple_norm_g': ple_norm_g[l],
            'w_ple_gate': w_ple_gate[l], 'w_ple_proj': w_ple_proj[l],
        }
        zero_h = jnp.zeros((xp.shape[0], A_HEADS, A_DK, A_DV), jnp.float32)
        zero_c = jnp.zeros((xp.shape[0], CONV_W - 1, 2 * D_FF), xp.dtype)
        xp, h_new, k_new, v_new, _, c_new = trunk_layer(xp, p_prompt[l], lbs[l], zero_h, None, None, zero_c, w, False)
        hp.append(h_new); kp.append(k_new); vp.append(v_new); cp.append(c_new)
        xs, h_new, k_new, v_new, g_new, c_new = trunk_layer(xs, p_sample[l], lbs[l], state_hgrn[l], cache_swa_k[l],
                                                            cache_swa_v[l], state_ffn_conv[l], w, True)
        hs.append(h_new); ksm.append(k_new); vsm.append(v_new); gs.append(g_new); cs.append(c_new)
    return (xp, xs, jnp.stack(hp), jnp.stack(hs), jnp.stack(kp), jnp.stack(vp), jnp.stack(ksm), jnp.stack(vsm),
            jnp.stack(gs), jnp.stack(cp), jnp.stack(cs))
```

```cpp
#include <hip/hip_runtime.h>
#include <hip/hip_cooperative_groups.h>
#include <cstdio>
#include <cstdint>
namespace cg = cooperative_groups;

#define LAS __attribute__((address_space(3)))
typedef unsigned short bf16_t;
typedef short bf16x8 __attribute__((ext_vector_type(8)));
typedef float f32x4 __attribute__((ext_vector_type(4)));
typedef float f32x2 __attribute__((ext_vector_type(2)));
typedef unsigned u32x4 __attribute__((ext_vector_type(4)));
typedef unsigned u32x2 __attribute__((ext_vector_type(2)));

constexpr int DM = 2048, SEQ = 2048, NBATCH = 8, MPR = NBATCH * SEQ  , NSAMP = 128, MV = MPR + NSAMP  , MP = 16640  ;
constexpr int DIN = 5888, DFF = 5632, DFF2 = 11264, PLE = 256;
constexpr float EPS = 1e-6f;
constexpr float RS_SCALE = 16777216.0f;
typedef unsigned long long u64;
constexpr int ZQ = 0, ZF = 1024, ZI = 2048, ZG = 3072, ZSQ = 4096, ZSK = 4608, ZSV = 4736, ZU = 4864, ZVR = 5376;
constexpr size_t O_Y = 0;
constexpr size_t O_HP = (size_t)MV * DM;
constexpr size_t O_HS = O_HP + (size_t)2 * 8 * 8 * 16384;
constexpr size_t O_KP = O_HS + (size_t)2 * 128 * 8 * 16384;
constexpr size_t O_VP = O_KP + (size_t)2 * 8 * 128 * 128;
constexpr size_t O_KS = O_VP + (size_t)2 * 8 * 128 * 128;
constexpr size_t O_VS = O_KS + (size_t)2 * 128 * 128 * 128;
constexpr size_t O_GS = O_VS + (size_t)2 * 128 * 128 * 128;
constexpr size_t O_CP = O_GS + (size_t)2 * 128 * 512;
constexpr size_t O_CS = O_CP + (size_t)2 * 8 * 2 * DFF2;
constexpr size_t WS_RS = 0;
constexpr size_t WS_LBS = 1u << 20;
constexpr size_t WS_WT = 2u << 20;
constexpr size_t WT_IN = 0, WT_OUT = WT_IN + (size_t)DIN * DM, WT_UP = WT_OUT + (size_t)DM * DM, WT_DOWN = WT_UP + (size_t)DFF2 * DM,
                 WT_GATE = WT_DOWN + (size_t)DM * DFF, WT_PROJ = WT_GATE + (size_t)DM * DM, WT_LAYER = WT_PROJ + (size_t)DM * PLE;
constexpr size_t XB_BYTES = (size_t)MP * DM * 2;
constexpr size_t WS_XB0 = WS_WT + 2 * WT_LAYER * 2;
constexpr size_t WS_XB1 = WS_XB0 + XB_BYTES;
constexpr size_t WS_PB = WS_XB1 + XB_BYTES;
constexpr size_t WS_R = WS_PB + (size_t)2 * MP * PLE * 2;
constexpr size_t WS_Z = WS_R;
constexpr size_t WS_LF = WS_Z + (size_t)MP * DIN * 2;
constexpr size_t WS_MIX = WS_LF + (size_t)MP * 1024 * 4;
constexpr size_t WS_ACT = WS_R;
constexpr size_t WS_SIDE = WS_ACT + (size_t)MP * DFF * 2;
constexpr size_t WS_END = WS_MIX + (size_t)MP * DM * 2;
static_assert(WS_SIDE + (size_t)(MP / 64) * 4 * DFF2 * 2 <= WS_END, "side fits");
constexpr size_t HL_BYTES = (size_t)1024 * 16384 * 4;
static_assert(HL_BYTES + (size_t)1024 * 128 * 4 <= XB_BYTES, "hgrn chunk buffers fit in one XB buffer");
constexpr size_t WS_HSIN = WS_LF;
constexpr size_t WS_BAR = WS_RS + 983040;
constexpr int LDS_BYTES = 147456;
constexpr int LDS_ST_OFF = LDS_BYTES - 16;

struct Params { const float* in[28]; float* out; unsigned char* ws; };

__device__ __forceinline__ float bf2f(unsigned u16) { return __uint_as_float(u16 << 16); }
__device__ __forceinline__ unsigned f2bf(float f) { unsigned u = __float_as_uint(f); return (u + 0x7fffu + ((u >> 16) & 1u)) >> 16; }
typedef __bf16 bf16v2 __attribute__((ext_vector_type(2)));
__device__ __forceinline__ unsigned pk2(float lo, float hi) { bf16v2 v; v[0] = (__bf16)lo; v[1] = (__bf16)hi; return __builtin_bit_cast(unsigned, v); }
__device__ __forceinline__ float lo16(unsigned w) { return __uint_as_float(w << 16); }
__device__ __forceinline__ float hi16(unsigned w) { return __uint_as_float(w & 0xffff0000u); }
__device__ __forceinline__ float wave_sum(float v) {
#pragma unroll
    for (int o = 1; o < 64; o <<= 1) v += __shfl_xor(v, o);
    return v;
}
__device__ __forceinline__ float wave_max(float v) {
#pragma unroll
    for (int o = 1; o < 64; o <<= 1) v = fmaxf(v, __shfl_xor(v, o));
    return v;
}
__device__ __forceinline__ float rs_rstd(const u64* rs, int r) { return rsqrtf((float)rs[r] * (1.0f / (RS_SCALE * DM)) + EPS); }
__device__ __forceinline__ float fsigmoid(float v) { return __builtin_amdgcn_rcpf(1.0f + __expf(-v)); }
__device__ __forceinline__ float fsilu(float v) { return v * fsigmoid(v); }
__device__ __forceinline__ float fgelu(float v) { const float u = 0.7978845608f * (v + 0.044715f * v * v * v); return v * fsigmoid(2.0f * u); }
__device__ __forceinline__ float dpp_ror1(float x) { return __int_as_float(__builtin_amdgcn_update_dpp(0, __float_as_int(x), 0x121, 0xf, 0xf, false)); }
__device__ __forceinline__ float dpp_ror2(float x) { return __int_as_float(__builtin_amdgcn_update_dpp(0, __float_as_int(x), 0x122, 0xf, 0xf, false)); }
__device__ __forceinline__ float dpp_shr1(float old, float x) { return __int_as_float(__builtin_amdgcn_update_dpp(__float_as_int(old), __float_as_int(x), 0x111, 0xf, 0xf, false)); }
__device__ __forceinline__ float dpp_shr2(float old, float x) { return __int_as_float(__builtin_amdgcn_update_dpp(__float_as_int(old), __float_as_int(x), 0x112, 0xf, 0xf, false)); }
__device__ __forceinline__ bf16x8 frag(const LAS unsigned char* base, int stride_el, int row, int kofs) {
    return *(const LAS bf16x8*)(base + (size_t)(row * stride_el + kofs) * 2);
}
__device__ __forceinline__ int get_tid(int wv) { asm volatile("" : "+s"(wv)); int ln; asm volatile("v_mbcnt_lo_u32_b32 %0, -1, 0\n\tv_mbcnt_hi_u32_b32 %0, -1, %0" : "=v"(ln)); int t = wv * 64 + ln; asm volatile("" : "+v"(t)); return t; }
__device__ __forceinline__ int swz8(int k) { return k ^ ((k >> 3) & 7); }
#define MFMA16(a, b, c) __builtin_amdgcn_mfma_f32_16x16x32_bf16((a), (b), (c), 0, 0, 0)

namespace pg8 {
constexpr int BM = 256, BK = 64, HALF = 128, HTB = HALF * BK * 2, STAGE_BYTES = 8 * HTB, NXCD = 8, WGM = 8;
__device__ __forceinline__ int lds_byte(int r, int c) { const int st = (r >> 4) * 2 + (c >> 5), rr = r & 15, cc = c & 31, ob = rr * 64 + cc * 2; return st * 1024 + (ob ^ (((ob >> 9) & 1) << 5)); }
__device__ __forceinline__ void stage_rc(int b, int& R, int& C) { const int st = b / 1024, sb = b % 1024, swz = sb ^ (((sb >> 9) & 1) << 5); R = (st >> 1) * 16 + swz / 64; C = (st & 1) * 32 + (swz % 64) / 2; }
__device__ __forceinline__ int perm32(int rho) { const int n = rho >> 4, i = rho & 15; return 8 * (i >> 2) + 4 * n + (i & 3); }
struct Unit { int pm, pn; };
struct Gemm { const bf16_t* A; const bf16_t* Bt; int lda, K, nM, nN; };
struct StaticOrder {
    int nM, nN, nwg, G, c;
    __device__ __forceinline__ void init(int nM_, int nN_, int G_, int c_) { nM = nM_; nN = nN_; nwg = nM * nN; G = G_; c = c_; }
    __device__ __forceinline__ bool next(int i, Unit& u) const {
        const long L = (long)i * G + c; if (L >= nwg) return false;
        int wgid = (int)L; { const int q = nwg / NXCD, r = nwg % NXCD, xcd = wgid % NXCD, off = wgid / NXCD; wgid = (xcd < r ? xcd * (q + 1) : r * (q + 1) + (xcd - r) * q) + off; }
        const int nig = WGM * nN, gid = wgid / nig, fm = gid * WGM, gsz = (nM - fm) < WGM ? (nM - fm) : WGM;
        u.pm = fm + ((wgid % nig) % gsz); u.pn = (wgid % nig) / gsz; return true;
    }
};
template <class Epi>
__device__ __forceinline__ void gemm_phase(int wv, LAS unsigned char* lds, const Gemm g, const StaticOrder& S, const Epi& E) {
    const int tid = get_tid(wv) & 511;
    const int wid = __builtin_amdgcn_readfirstlane(tid >> 6) & 7, lane = tid & 63, wr = wid >> 2, wc = wid & 3, fr = lane & 15, fq = lane >> 4;
    const int K = g.K, nt = K / BK, lda = g.lda;
    unsigned voffA[2], voffB[2];
#pragma unroll
    for (int i = 0; i < 2; ++i) { int R, C; stage_rc(tid * 16 + i * 8192, R, C); const int Rb = (R & ~31) + perm32(R & 31);
        voffA[i] = (unsigned)(R * lda + C) * 2u; voffB[i] = (unsigned)(Rb * K + C) * 2u; }
    const size_t kstep = (size_t)(BK * 2);
    const size_t hstepA = (size_t)HALF * lda * 2, hstepB = (size_t)HALF * K * 2;
    const size_t tstepA = 2 * hstepA, tstepB = 2 * hstepB;
    const unsigned ldsw = (unsigned)wid * 1024u;
    const int aoff = lds_byte(wr * 64 + fr, fq * 8), boff = lds_byte(wc * 32 + fr, fq * 8);
#define PG8_SA(b, h) (((b) * 2 + (h)) * HTB)
#define PG8_SB(b, h) ((4 + (b) * 2 + (h)) * HTB)
#define PG8_STAGE(bufoff, gbase, voff) do { _Pragma("unroll") for (int _i = 0; _i < 2; ++_i) \
        __builtin_amdgcn_global_load_lds((const unsigned*)((const char*)(gbase) + (voff)[_i]), (LAS unsigned*)(lds + (bufoff) + ldsw + _i * 8192), 16, 0, 0); } while (0)
#define PG8_LDA(dst, b, h) do { _Pragma("unroll") for (int m = 0; m < 4; ++m) _Pragma("unroll") for (int k = 0; k < 2; ++k) dst[m][k] = *(const LAS bf16x8*)(lds + PG8_SA(b, h) + aoff + m * 2048 + k * 1024); } while (0)
#define PG8_LDB(dst, b, h) do { _Pragma("unroll") for (int n = 0; n < 2; ++n) _Pragma("unroll") for (int k = 0; k < 2; ++k) dst[n][k] = *(const LAS bf16x8*)(lds + PG8_SB(b, h) + boff + n * 2048 + k * 1024); } while (0)
#define PG8_MMA(ai, bj, At, Bt) do { __builtin_amdgcn_s_setprio(1); _Pragma("unroll") for (int m = 0; m < 4; ++m) _Pragma("unroll") for (int n = 0; n < 2; ++n) _Pragma("unroll") for (int k = 0; k < 2; ++k) \
        acc[ai][bj][m][n] = __builtin_amdgcn_mfma_f32_16x16x32_bf16(Bt[n][k], At[m][k], acc[ai][bj][m][n], 0, 0, 0); __builtin_amdgcn_s_setprio(0); } while (0)
#define PG8_WAIT_V(n) asm volatile("s_waitcnt vmcnt(" #n ")" ::: "memory")
#define PG8_WAIT_L(n) asm volatile("s_waitcnt lgkmcnt(" #n ")" ::: "memory")
#define PG8_BAR __builtin_amdgcn_s_barrier()
#define PG8_SCHED __builtin_amdgcn_sched_barrier(0)
    Unit cur, nxt; int ui = 0;
    if (!S.next(0, cur)) return;
    f32x4 acc[2][2][4][2];
#pragma unroll
    for (int a = 0; a < 2; ++a)
#pragma unroll
        for (int b = 0; b < 2; ++b)
#pragma unroll
            for (int m = 0; m < 4; ++m)
#pragma unroll
                for (int n = 0; n < 2; ++n) acc[a][b][m][n] = (f32x4){0.f, 0.f, 0.f, 0.f};
    bf16x8 At[4][2], B0[2][2], B1[2][2];
    const char* cA = (const char*)g.A + (size_t)cur.pm * tstepA; const char* cB = (const char*)g.Bt + (size_t)cur.pn * tstepB;
    PG8_STAGE(PG8_SB(0, 0), cB, voffB); PG8_STAGE(PG8_SB(0, 1), cB + hstepB, voffB); PG8_STAGE(PG8_SA(0, 0), cA, voffA); PG8_STAGE(PG8_SA(0, 1), cA + hstepA, voffA);
    if (wr == 1) PG8_BAR;
    PG8_WAIT_V(2); PG8_BAR;
    PG8_STAGE(PG8_SB(1, 0), cB + kstep, voffB); PG8_STAGE(PG8_SA(1, 0), cA + kstep, voffA); PG8_STAGE(PG8_SB(1, 1), cB + hstepB + kstep, voffB);
    PG8_WAIT_V(6); PG8_BAR;
    for (;;) {
        const bool has_next = S.next(ui + 1, nxt);
        const char* nA = has_next ? (const char*)g.A + (size_t)nxt.pm * tstepA : cA; const char* nB = has_next ? (const char*)g.Bt + (size_t)nxt.pn * tstepB : cB;
        for (int t = 0; t < nt; t += 2) {
            const bool last = (t == nt - 2);
            const char* a1 = cA + (size_t)(t + 1) * kstep;
            const char* a2 = last ? nA : cA + (size_t)(t + 2) * kstep; const char* b2 = last ? nB : cB + (size_t)(t + 2) * kstep;
            const char* a3 = a2 + kstep; const char* b3 = b2 + kstep;
            PG8_LDB(B0, 0, 0); PG8_LDB(B1, 0, 1); PG8_SCHED; PG8_LDA(At, 0, 0); PG8_STAGE(PG8_SA(1, 1), a1 + hstepA, voffA);
            PG8_WAIT_V(8); PG8_WAIT_L(0); PG8_BAR; PG8_MMA(0, 0, At, B0); PG8_MMA(0, 1, At, B1); PG8_BAR; PG8_SCHED;
            PG8_LDA(At, 0, 1); PG8_STAGE(PG8_SB(0, 0), b2, voffB); PG8_STAGE(PG8_SB(0, 1), b2 + hstepB, voffB); PG8_STAGE(PG8_SA(0, 0), a2, voffA);
            PG8_WAIT_V(8); PG8_WAIT_L(0); PG8_BAR; PG8_MMA(1, 0, At, B0); PG8_MMA(1, 1, At, B1); PG8_BAR; PG8_SCHED;
            PG8_LDB(B0, 1, 0); PG8_LDB(B1, 1, 1); PG8_SCHED; PG8_LDA(At, 1, 0); PG8_STAGE(PG8_SA(0, 1), a2 + hstepA, voffA);
            PG8_WAIT_V(8); PG8_WAIT_L(0); PG8_BAR; PG8_MMA(0, 0, At, B0); PG8_MMA(0, 1, At, B1); PG8_BAR; PG8_SCHED;
            PG8_LDA(At, 1, 1); PG8_STAGE(PG8_SB(1, 0), b3, voffB); PG8_STAGE(PG8_SB(1, 1), b3 + hstepB, voffB); PG8_STAGE(PG8_SA(1, 0), a3, voffA);
            PG8_WAIT_V(8); PG8_WAIT_L(0); PG8_BAR; PG8_MMA(1, 0, At, B0); PG8_MMA(1, 1, At, B1); PG8_BAR; PG8_SCHED;
        }
        if (wr == 0) PG8_BAR;
        { const int t2 = get_tid(wv); E(acc, cur, wr, wc, t2 & 15, (t2 >> 4) & 3); }
        if (!has_next) break;
#pragma unroll
        for (int a = 0; a < 2; ++a)
#pragma unroll
            for (int b = 0; b < 2; ++b)
#pragma unroll
                for (int m = 0; m < 4; ++m)
#pragma unroll
                    for (int n = 0; n < 2; ++n) acc[a][b][m][n] = (f32x4){0.f, 0.f, 0.f, 0.f};
        cur = nxt; cA = nA; cB = nB; ++ui;
        if (wr == 1) PG8_BAR;
    }
    PG8_WAIT_V(0);
    PG8_BAR;
#undef PG8_SA
#undef PG8_SB
#undef PG8_STAGE
#undef PG8_LDA
#undef PG8_LDB
#undef PG8_MMA
#undef PG8_WAIT_V
#undef PG8_WAIT_L
#undef PG8_BAR
#undef PG8_SCHED
}
}
using pg8::Unit;
typedef f32x4 Acc[2][2][4][2];

struct EpiIn {
    bf16_t* Z; float* LF; const u64* rs; const float* lb;
    __device__ __forceinline__ void operator()(const Acc& acc, const Unit& u, int wr, int wc, int fr, int fq) const {
        asm volatile("" : "+v"(fr), "+v"(fq));
        const int pn = u.pn;
        const int kind = (pn < 4) ? 0 : (pn < 8) ? 1 : (pn < 12) ? 2 : (pn < 16) ? 0 : (pn < 19) ? 2 : 3;
        float rstdv[2][4];
#pragma unroll
        for (int ai = 0; ai < 2; ++ai)
#pragma unroll
            for (int m = 0; m < 4; ++m) { const int r = u.pm * 256 + ai * 128 + wr * 64 + m * 16 + fr; rstdv[ai][m] = rs_rstd(rs, r); }
        f32x4 lbv[2][2];
#pragma unroll
        for (int bj = 0; bj < 2; ++bj) { lbv[bj][0] = (f32x4){0.f, 0.f, 0.f, 0.f}; lbv[bj][1] = lbv[bj][0]; }
        if (kind == 1) {
#pragma unroll
            for (int bj = 0; bj < 2; ++bj) { const int cf = pn * 256 + bj * 128 + wc * 32 + 8 * fq - ZF; lbv[bj][0] = *(const f32x4*)(lb + cf); lbv[bj][1] = *(const f32x4*)(lb + cf + 4); }
        }
#pragma unroll
        for (int ai = 0; ai < 2; ++ai)
#pragma unroll
            for (int m = 0; m < 4; ++m) {
                const int r = u.pm * 256 + ai * 128 + wr * 64 + m * 16 + fr;
                const float rstd = rstdv[ai][m];
#pragma unroll
                for (int bj = 0; bj < 2; ++bj) {
                    const int c = pn * 256 + bj * 128 + wc * 32 + 8 * fq;
                    f32x4 v0 = acc[ai][bj][m][0] * rstd, v1 = acc[ai][bj][m][1] * rstd;
                    if (kind == 1) {
                        const int cf = c - ZF;
                        const f32x4 l0 = lbv[bj][0], l1 = lbv[bj][1];
                        f32x4 o0, o1;
#pragma unroll
                        for (int j = 0; j < 4; ++j) { o0[j] = __logf(l0[j] + (1.0f - l0[j]) * fsigmoid(v0[j])); o1[j] = __logf(l1[j] + (1.0f - l1[j]) * fsigmoid(v1[j])); }
                        float* d = LF + (size_t)r * 1024 + cf; *(f32x4*)d = o0; *(f32x4*)(d + 4) = o1;
                    } else {
                        if (kind == 0) {
#pragma unroll
                            for (int j = 0; j < 4; ++j) { v0[j] = fsilu(v0[j]); v1[j] = fsilu(v1[j]); }
                        } else if (kind == 3) {
#pragma unroll
                            for (int j = 0; j < 4; ++j) { v0[j] = fgelu(v0[j]); v1[j] = fgelu(v1[j]); }
                        }
                        u32x4 w; w.x = pk2(v0[0], v0[1]); w.y = pk2(v0[2], v0[3]); w.z = pk2(v1[0], v1[1]); w.w = pk2(v1[2], v1[3]);
                        *(u32x4*)(Z + (size_t)r * DIN + c) = w;
                    }
                }
            }
    }
};
struct EpiRes {
    const bf16_t* RB; bf16_t* XB; u64* rs_out;
    __device__ __forceinline__ void operator()(const Acc& acc, const Unit& u, int wr, int wc, int fr, int fq) const {
        asm volatile("" : "+v"(fr), "+v"(fq));
        u32x4 rv[2][4][2];
#pragma unroll
        for (int ai = 0; ai < 2; ++ai)
#pragma unroll
            for (int m = 0; m < 4; ++m)
#pragma unroll
                for (int bj = 0; bj < 2; ++bj) rv[ai][m][bj] = *(const u32x4*)(RB + (size_t)(u.pm * 256 + ai * 128 + wr * 64 + m * 16 + fr) * DM + u.pn * 256 + bj * 128 + wc * 32 + 8 * fq);
#pragma unroll
        for (int ai = 0; ai < 2; ++ai)
#pragma unroll
            for (int m = 0; m < 4; ++m) {
                const int r = u.pm * 256 + ai * 128 + wr * 64 + m * 16 + fr;
                float ss = 0.f;
#pragma unroll
                for (int bj = 0; bj < 2; ++bj) {
                    const int c = u.pn * 256 + bj * 128 + wc * 32 + 8 * fq;
                    const u32x4 w0 = rv[ai][m][bj];
                    const f32x4 y0 = (f32x4){lo16(w0.x), hi16(w0.x), lo16(w0.y), hi16(w0.y)} + acc[ai][bj][m][0], y1 = (f32x4){lo16(w0.z), hi16(w0.z), lo16(w0.w), hi16(w0.w)} + acc[ai][bj][m][1];
                    u32x4 w; w.x = pk2(y0[0], y0[1]); w.y = pk2(y0[2], y0[3]); w.z = pk2(y1[0], y1[1]); w.w = pk2(y1[2], y1[3]);
                    *(u32x4*)(XB + (size_t)r * DM + c) = w;
                    ss += (y0[0] * y0[0] + y0[1] * y0[1]) + (y0[2] * y0[2] + y0[3] * y0[3]) + (y1[0] * y1[0] + y1[1] * y1[1]) + (y1[2] * y1[2] + y1[3] * y1[3]);
                }
                ss += __shfl_xor(ss, 16); ss += __shfl_xor(ss, 32);
                if (fq == 0) atomicAdd(rs_out + r, (u64)(ss * RS_SCALE));
            }
    }
};
struct EpiUp {
    bf16_t* ACT; bf16_t* SIDE; const u64* rs; const float* cw; const float* cb; float* conv_p; float* conv_s;
    __device__ __forceinline__ void operator()(const Acc& acc, const Unit& u, int wr, int wc, int fr, int fq) const {
        asm volatile("" : "+v"(fr), "+v"(fq));
        const int pn = u.pn;
        {
            float rstdv[2][4];
#pragma unroll
            for (int ai = 0; ai < 2; ++ai)
#pragma unroll
                for (int m = 0; m < 4; ++m) rstdv[ai][m] = rs_rstd(rs, u.pm * 256 + ai * 128 + wr * 64 + m * 16 + fr);
#pragma unroll
            for (int n = 0; n < 2; ++n) {
                __builtin_amdgcn_sched_barrier(0);
                const int ca = pn * 128 + wc * 32 + 8 * fq + 4 * n;
                f32x4 wgn[3], wvn[3];
#pragma unroll
                for (int k = 0; k < 3; ++k) { wgn[k] = *(const f32x4*)(cw + k * DFF2 + ca); wvn[k] = *(const f32x4*)(cw + k * DFF2 + DFF + ca); }
                const f32x4 bgn = *(const f32x4*)(cb + ca), bvn = *(const f32x4*)(cb + DFF + ca);
#pragma unroll
                for (int ai = 0; ai < 2; ++ai) {
                    f32x4 pg = (f32x4){0.f, 0.f, 0.f, 0.f}, pv = pg;
#pragma unroll
                    for (int m = 0; m < 4; ++m) {
                        const int r = u.pm * 256 + ai * 128 + wr * 64 + m * 16 + fr;
                        const float rstd = rstdv[ai][m];
                        const f32x4 xg = acc[ai][0][m][n] * rstd, xv = acc[ai][1][m][n] * rstd;
                        f32x4 o;
#pragma unroll
                        for (int j = 0; j < 4; ++j) {
                            const float g1 = dpp_shr1(dpp_ror1(pg[j]), xg[j]), g2 = dpp_shr2(dpp_ror2(pg[j]), xg[j]);
                            const float v1 = dpp_shr1(dpp_ror1(pv[j]), xv[j]), v2 = dpp_shr2(dpp_ror2(pv[j]), xv[j]);
                            const float cg_ = bgn[j] + wgn[0][j] * g2 + wgn[1][j] * g1 + wgn[2][j] * xg[j];
                            const float cv_ = bvn[j] + wvn[0][j] * v2 + wvn[1][j] * v1 + wvn[2][j] * xv[j];
                            o[j] = fsilu(cg_) * cv_;
                        }
                        if (!(m == 0 && fr < 2)) { u32x2 w; w.x = pk2(o[0], o[1]); w.y = pk2(o[2], o[3]); *(u32x2*)(ACT + (size_t)r * DFF + ca) = w; }
                        if ((m == 0 && fr < 2) || (m == 3 && fr >= 14)) {
                            const int slot = (m == 0) ? 2 + fr : fr - 14;
                            bf16_t* sd = SIDE + ((size_t)(r >> 6) * 4 + slot) * DFF2 + ca;
                            u32x2 w2; w2.x = pk2(xg[0], xg[1]); w2.y = pk2(xg[2], xg[3]); *(u32x2*)sd = w2;
                            w2.x = pk2(xv[0], xv[1]); w2.y = pk2(xv[2], xv[3]); *(u32x2*)(sd + DFF) = w2;
                        }
                        if (m == 3 && fr >= 14 && (r & 2047) >= 2046) {
                            float* d = conv_p + ((size_t)(r >> 11) * 2 + ((r & 2047) - 2046)) * DFF2 + ca;
                            *(f32x4*)d = xg; *(f32x4*)(d + DFF) = xv;
                        }
                        pg = xg; pv = xv;
                    }
                }
            }
        }
    }
};
struct EpiProj {
    bf16_t* O;
    __device__ __forceinline__ void operator()(const Acc& acc, const Unit& u, int wr, int wc, int fr, int fq) const {
        asm volatile("" : "+v"(fr), "+v"(fq));
#pragma unroll
        for (int ai = 0; ai < 2; ++ai)
#pragma unroll
            for (int m = 0; m < 4; ++m) {
                const int r = u.pm * 256 + ai * 128 + wr * 64 + m * 16 + fr;
#pragma unroll
                for (int bj = 0; bj < 2; ++bj) {
                    const int c = u.pn * 256 + bj * 128 + wc * 32 + 8 * fq;
                    const f32x4 v0 = acc[ai][bj][m][0], v1 = acc[ai][bj][m][1];
                    u32x4 w; w.x = pk2(v0[0], v0[1]); w.y = pk2(v0[2], v0[3]); w.z = pk2(v1[0], v1[1]); w.w = pk2(v1[2], v1[3]);
                    *(u32x4*)(O + (size_t)r * DM + c) = w;
                }
            }
    }
};
struct EpiGate {
    const bf16_t* RB; const bf16_t* PP; bf16_t* XBo; float* Xout; const u64* rs; u64* rs_out;
    __device__ __forceinline__ void operator()(const Acc& acc, const Unit& u, int wr, int wc, int fr, int fq) const {
        asm volatile("" : "+v"(fr), "+v"(fq));
        float rstdv[2][4];
#pragma unroll
        for (int ai = 0; ai < 2; ++ai)
#pragma unroll
            for (int m = 0; m < 4; ++m) rstdv[ai][m] = rs_rstd(rs, u.pm * 256 + ai * 128 + wr * 64 + m * 16 + fr);
#pragma unroll
        for (int ai = 0; ai < 2; ++ai) {
            u32x4 pw[4][2], xw[4][2];
#pragma unroll
            for (int m = 0; m < 4; ++m)
#pragma unroll
                for (int bj = 0; bj < 2; ++bj) { const size_t o = (size_t)(u.pm * 256 + ai * 128 + wr * 64 + m * 16 + fr) * DM + u.pn * 256 + bj * 128 + wc * 32 + 8 * fq;
                    pw[m][bj] = *(const u32x4*)(PP + o); xw[m][bj] = *(const u32x4*)(RB + o); }
#pragma unroll
            for (int m = 0; m < 4; ++m) {
                const int r = u.pm * 256 + ai * 128 + wr * 64 + m * 16 + fr;
                float ss = 0.f;
#pragma unroll
                for (int bj = 0; bj < 2; ++bj) {
                    const int c = u.pn * 256 + bj * 128 + wc * 32 + 8 * fq;
                    const f32x4 a0 = acc[ai][bj][m][0] * rstdv[ai][m], a1 = acc[ai][bj][m][1] * rstdv[ai][m];
                    const u32x4 pq = pw[m][bj], xq = xw[m][bj];
                    f32x4 y0, y1;
                    y0[0] = lo16(xq.x) + fsigmoid(a0[0]) * lo16(pq.x); y0[1] = hi16(xq.x) + fsigmoid(a0[1]) * hi16(pq.x);
                    y0[2] = lo16(xq.y) + fsigmoid(a0[2]) * lo16(pq.y); y0[3] = hi16(xq.y) + fsigmoid(a0[3]) * hi16(pq.y);
                    y1[0] = lo16(xq.z) + fsigmoid(a1[0]) * lo16(pq.z); y1[1] = hi16(xq.z) + fsigmoid(a1[1]) * hi16(pq.z);
                    y1[2] = lo16(xq.w) + fsigmoid(a1[2]) * lo16(pq.w); y1[3] = hi16(xq.w) + fsigmoid(a1[3]) * hi16(pq.w);
                    if (Xout) { float* d = Xout + (size_t)r * DM + c; *(f32x4*)d = y0; *(f32x4*)(d + 4) = y1; }
                    else { u32x4 w; w.x = pk2(y0[0], y0[1]); w.y = pk2(y0[2], y0[3]); w.z = pk2(y1[0], y1[1]); w.w = pk2(y1[2], y1[3]);
                        *(u32x4*)(XBo + (size_t)r * DM + c) = w; }
                    ss += (y0[0] * y0[0] + y0[1] * y0[1]) + (y0[2] * y0[2] + y0[3] * y0[3]) + (y1[0] * y1[0] + y1[1] * y1[1]) + (y1[2] * y1[2] + y1[3] * y1[3]);
                }
                ss += __shfl_xor(ss, 16); ss += __shfl_xor(ss, 32);
                if (fq == 0 && !Xout) atomicAdd(rs_out + r, (u64)(ss * RS_SCALE));
            }
        }
    }
};

template <int NT, class Epi>
__device__ __forceinline__ void skinny_phase(int wv, LAS unsigned char* lds, const bf16_t* A, int lda, const bf16_t* Bt, int K, int nstrips, const Epi& E, int nslack = 0) {
    const int tid = get_tid(wv) & 511; const int lane = tid & 63, wave = __builtin_amdgcn_readfirstlane(tid >> 6) & 7, i16 = lane & 15, q4 = lane >> 4;
    const int G = gridDim.x;
    LAS bf16_t* AL = (LAS bf16_t*)lds;
    LAS bf16_t* BL = (LAS bf16_t*)(lds + 128 * 264 * 2);
    const int prow = tid >> 5, pk = (tid & 31) * 8;
    const int sstep = nslack > 0 ? nslack : G;
    if (nslack > 0 && (int)blockIdx.x < G - nslack) return;
    for (int s = G - 1 - (int)blockIdx.x; s < nstrips; s += sstep) {
        const int n0 = s * 16 * NT;
        f32x4 acc[NT];
#pragma unroll
        for (int nt = 0; nt < NT; ++nt) acc[nt] = (f32x4){0.f, 0.f, 0.f, 0.f};
        const bf16_t* ap = A + (size_t)prow * lda + pk;
        const bf16_t* bp = Bt + (size_t)(n0 + prow) * K + pk;
        u32x4 ra[8], rb[NT];
#pragma unroll
        for (int i = 0; i < 8; ++i) ra[i] = *(const u32x4*)(ap + (size_t)(16 * i) * lda);
#pragma unroll
        for (int nt = 0; nt < NT; ++nt) rb[nt] = *(const u32x4*)(bp + (size_t)(16 * nt) * K);
#pragma unroll 1
        for (int k0 = 0; k0 < K; k0 += 256) {
            __syncthreads();
#pragma unroll
            for (int i = 0; i < 8; ++i) *(LAS u32x4*)(AL + (prow + 16 * i) * 264 + pk) = ra[i];
#pragma unroll
            for (int nt = 0; nt < NT; ++nt) *(LAS u32x4*)(BL + (prow + 16 * nt) * 264 + pk) = rb[nt];
            __syncthreads();
            if (k0 + 256 < K) {
#pragma unroll
                for (int i = 0; i < 8; ++i) ra[i] = *(const u32x4*)(ap + (size_t)(16 * i) * lda + k0 + 256);
#pragma unroll
                for (int nt = 0; nt < NT; ++nt) rb[nt] = *(const u32x4*)(bp + (size_t)(16 * nt) * K + k0 + 256);
            }
#pragma unroll
            for (int u = 0; u < 8; ++u) { const bf16x8 a = frag((const LAS unsigned char*)AL, 264, 16 * wave + i16, 32 * u + 8 * q4);
#pragma unroll
                for (int nt = 0; nt < NT; ++nt) acc[nt] = MFMA16(a, frag((const LAS unsigned char*)BL, 264, 16 * nt + i16, 32 * u + 8 * q4), acc[nt]); }
        }
        { int i16v = i16, q4v = q4; asm volatile("" : "+v"(i16v), "+v"(q4v));
#pragma unroll
          for (int nt = 0; nt < NT; ++nt) E(acc[nt], wave, i16v, q4v, n0 + 16 * nt); }
    }
    __syncthreads();
}
struct SkIn {
    bf16_t* Z; float* LF; const u64* rs; const float* lb;
    __device__ __forceinline__ void operator()(const f32x4& acc, int wave, int i16, int q4, int nb) const {
        const int kind = (nb < 1024) ? 0 : (nb < 2048) ? 1 : (nb < 3072) ? 2 : (nb < 4096) ? 0 : (nb < 4864) ? 2 : 3;
        const int n = nb + i16;
#pragma unroll
        for (int jj = 0; jj < 4; ++jj) { const int r = MPR + 16 * wave + 4 * q4 + jj; const float v = acc[jj] * rs_rstd(rs, r);
            if (kind == 1) { const float lbv = lb[n - ZF]; LF[(size_t)r * 1024 + n - ZF] = __logf(lbv + (1.0f - lbv) * fsigmoid(v)); }
            else Z[(size_t)r * DIN + n] = (bf16_t)f2bf(kind == 0 ? fsilu(v) : kind == 3 ? fgelu(v) : v); }
    }
};
struct SkRes {
    const bf16_t* RB; bf16_t* XB; u64* rs_out;
    __device__ __forceinline__ void operator()(const f32x4& acc, int wave, int i16, int q4, int nb) const {
        const int n = nb + i16;
#pragma unroll
        for (int jj = 0; jj < 4; ++jj) { const int r = MPR + 16 * wave + 4 * q4 + jj; const float y = bf2f(RB[(size_t)r * DM + n]) + acc[jj];
            XB[(size_t)r * DM + n] = (bf16_t)f2bf(y);
            float ss = y * y; ss += __shfl_xor(ss, 1); ss += __shfl_xor(ss, 2); ss += __shfl_xor(ss, 4); ss += __shfl_xor(ss, 8);
            if (i16 == 0) atomicAdd(rs_out + r, (u64)(ss * RS_SCALE)); }
    }
};
struct SkUp {
    const u64* rs; float* conv_s;
    __device__ __forceinline__ void operator()(const f32x4& acc, int wave, int i16, int q4, int nb) const {
        const int n = nb + i16, orig = ((n >> 7) & 1) * DFF + (n >> 8) * 128 + (n & 127);
#pragma unroll
        for (int jj = 0; jj < 4; ++jj) { const int sidx = 16 * wave + 4 * q4 + jj; conv_s[(size_t)sidx * 2 * DFF2 + DFF2 + orig] = acc[jj] * rs_rstd(rs, MPR + sidx); }
    }
};
struct SkProj {
    bf16_t* O;
    __device__ __forceinline__ void operator()(const f32x4& acc, int wave, int i16, int q4, int nb) const {
#pragma unroll
        for (int jj = 0; jj < 4; ++jj) O[(size_t)(MPR + 16 * wave + 4 * q4 + jj) * DM + nb + i16] = (bf16_t)f2bf(acc[jj]);
    }
};
struct SkGate {
    const bf16_t* RB; const bf16_t* PP; bf16_t* XBo; float* Xout; const u64* rs; u64* rs_out;
    __device__ __forceinline__ void operator()(const f32x4& acc, int wave, int i16, int q4, int nb) const {
        const int n = nb + i16;
#pragma unroll
        for (int jj = 0; jj < 4; ++jj) { const int r = MPR + 16 * wave + 4 * q4 + jj;
            const float y = bf2f(RB[(size_t)r * DM + n]) + fsigmoid(acc[jj] * rs_rstd(rs, r)) * bf2f(PP[(size_t)r * DM + n]);
            if (Xout) Xout[(size_t)r * DM + n] = y;
            XBo[(size_t)r * DM + n] = (bf16_t)f2bf(y);
            float ss = y * y; ss += __shfl_xor(ss, 1); ss += __shfl_xor(ss, 2); ss += __shfl_xor(ss, 4); ss += __shfl_xor(ss, 8);
            if (i16 == 0) atomicAdd(rs_out + r, (u64)(ss * RS_SCALE)); }
    }
};

struct TrDesc { const float* W; bf16_t* WT; const float* gain; int K, N, k0, n0, s0; };
__device__ __forceinline__ TrDesc tr_decode(const Params& p, int it) {
    constexpr int I_IN = 32 * (DIN / 32), I_OUT = 32 * 64, I_UP = 32 * (DFF2 / 32), I_DOWN = (DFF / 64) * 64, I_GATE = 32 * 64, I_PROJ = 4 * 64;
    constexpr int I_LAYER = I_IN + I_OUT + I_UP + I_DOWN + I_GATE + I_PROJ;
    const int l = it / I_LAYER; int r = it % I_LAYER;
    bf16_t* wl = (bf16_t*)(p.ws + WS_WT) + (size_t)l * WT_LAYER;
    TrDesc d; bool up = false;
    if (r < I_IN) { d.W = p.in[9] + (size_t)l * DM * DIN; d.K = DM; d.N = DIN; d.WT = wl + WT_IN; d.gain = p.in[8] + l * DM; }
    else if ((r -= I_IN) < I_OUT) { d.W = p.in[19] + (size_t)l * DM * DM; d.K = DM; d.N = DM; d.WT = wl + WT_OUT; d.gain = nullptr; }
    else if ((r -= I_OUT) < I_UP) { d.W = p.in[21] + (size_t)l * DM * DFF2; d.K = DM; d.N = DFF2; d.WT = wl + WT_UP; d.gain = p.in[20] + l * DM; up = true; }
    else if ((r -= I_UP) < I_DOWN) { d.W = p.in[24] + (size_t)l * DFF * DM; d.K = DFF; d.N = DM; d.WT = wl + WT_DOWN; d.gain = nullptr; }
    else if ((r -= I_DOWN) < I_GATE) { d.W = p.in[26] + (size_t)l * DM * DM; d.K = DM; d.N = DM; d.WT = wl + WT_GATE; d.gain = p.in[25] + l * DM; }
    else { r -= I_GATE; d.W = p.in[27] + (size_t)l * PLE * DM; d.K = PLE; d.N = DM; d.WT = wl + WT_PROJ; d.gain = nullptr; }
    const int nblk = d.N / 32, kb = r / nblk, nb = r % nblk; d.k0 = 64 * kb; d.n0 = 32 * nb;
    d.s0 = up ? ((d.n0 >> 7) & 1) * DFF + (d.n0 >> 8) * 128 + (d.n0 & 127) : d.n0;
    return d;
}
__device__ __forceinline__ void tr_load(const TrDesc& d, int lane, float (&tv)[32]) {
#pragma unroll
    for (int i = 0; i < 32; ++i) { const int kk = 2 * i + (lane >> 5); tv[i] = d.W[(size_t)(d.k0 + kk) * d.N + d.s0 + (lane & 31)]; }
}
__device__ __forceinline__ void tr_store(const TrDesc& d, LAS float* scr, int lane, float (&tv)[32]) {
    if (d.gain) {
#pragma unroll
        for (int i = 0; i < 32; ++i) tv[i] *= d.gain[d.k0 + 2 * i + (lane >> 5)];
    }
#pragma unroll
    for (int i = 0; i < 32; ++i) scr[(2 * i + (lane >> 5)) * 33 + (lane & 31)] = tv[i];
    asm volatile("s_waitcnt lgkmcnt(0)" ::: "memory");
    const int c = lane & 7;
#pragma unroll
    for (int j = 0; j < 4; ++j) { const int n = (lane >> 3) + 8 * j; const LAS float* s = scr + (8 * c) * 33 + n;
        u32x4 o; o.x = pk2(s[0 * 33], s[1 * 33]); o.y = pk2(s[2 * 33], s[3 * 33]); o.z = pk2(s[4 * 33], s[5 * 33]); o.w = pk2(s[6 * 33], s[7 * 33]);
        *(u32x4*)(d.WT + (size_t)(d.n0 + n) * d.K + d.k0 + 8 * c) = o; }
    asm volatile("s_waitcnt lgkmcnt(0)" ::: "memory");
}
__device__ __forceinline__ void phase_prep(int wv, const Params& p, LAS unsigned char* lds) {
    const int tid = get_tid(wv); const int lane = tid & 63, wave = __builtin_amdgcn_readfirstlane(tid >> 6);
    const int G = gridDim.x, gw = blockIdx.x * 8 + wave, NGW = G * 8;
    const int gt = blockIdx.x * 512 + tid, NGT = G * 512;
    u64* RS = (u64*)(p.ws + WS_RS);
    for (int i = gt; i < 6 * MP; i += NGT) RS[MP + i] = 0ull;
    float* LBS = (float*)(p.ws + WS_LBS);
    for (int i = gt; i < 1024; i += NGT) { LBS[i] = 0.f; LBS[1024 + i] = 1.0f / (1.0f + __expf(p.in[10][i] - p.in[10][1024 + i])); }
    LAS float* scr = (LAS float*)(lds + wave * 16384);
    constexpr int I_TOTAL = 2 * (32 * (DIN / 32) + 32 * 64 + 32 * (DFF2 / 32) + (DFF / 64) * 64 + 32 * 64 + 4 * 64);
    {
        float tva[32], tvb[32];
        int it = gw;
        TrDesc da = tr_decode(p, it < I_TOTAL ? it : 0), db = da;
        if (it < I_TOTAL) tr_load(da, lane, tva);
        while (it < I_TOTAL) {
            const int nx = it + NGW;
            if (nx < I_TOTAL) { db = tr_decode(p, nx); tr_load(db, lane, tvb); }
            tr_store(da, scr, lane, tva);
            it = nx;
            if (it >= I_TOTAL) break;
            const int nx2 = it + NGW;
            if (nx2 < I_TOTAL) { da = tr_decode(p, nx2); tr_load(da, lane, tva); }
            tr_store(db, scr, lane, tvb);
            it = nx2;
        }
    }
    bf16_t* XB0 = (bf16_t*)(p.ws + WS_XB0);
    for (int r0 = gw; r0 < MV; r0 += 2 * NGW) {
        const int r1 = r0 + NGW; const bool has1 = r1 < MV; const int r1c = has1 ? r1 : r0;
        const float* s0 = (r0 < MPR) ? p.in[0] + (size_t)r0 * DM : p.in[1] + (size_t)(r0 - MPR) * DM;
        const float* s1 = (r1c < MPR) ? p.in[0] + (size_t)r1c * DM : p.in[1] + (size_t)(r1c - MPR) * DM;
        f32x4 va[8], vb[8];
#pragma unroll
        for (int j = 0; j < 8; ++j) { va[j] = *(const f32x4*)(s0 + j * 256 + lane * 4); vb[j] = *(const f32x4*)(s1 + j * 256 + lane * 4); }
        float ssa = 0.f, ssb = 0.f;
#pragma unroll
        for (int j = 0; j < 8; ++j) { ssa += (va[j][0] * va[j][0] + va[j][1] * va[j][1]) + (va[j][2] * va[j][2] + va[j][3] * va[j][3]);
            ssb += (vb[j][0] * vb[j][0] + vb[j][1] * vb[j][1]) + (vb[j][2] * vb[j][2] + vb[j][3] * vb[j][3]); }
#pragma unroll
        for (int j = 0; j < 8; ++j) { u32x2 w; w.x = pk2(va[j][0], va[j][1]); w.y = pk2(va[j][2], va[j][3]); *(u32x2*)(XB0 + (size_t)r0 * DM + j * 256 + lane * 4) = w;
            if (has1) { w.x = pk2(vb[j][0], vb[j][1]); w.y = pk2(vb[j][2], vb[j][3]); *(u32x2*)(XB0 + (size_t)r1 * DM + j * 256 + lane * 4) = w; } }
        ssa = wave_sum(ssa); ssb = wave_sum(ssb);
        if (lane == 0) { RS[r0] = (u64)(ssa * RS_SCALE); if (has1) RS[r1] = (u64)(ssb * RS_SCALE); }
    }
    bf16_t* PB = (bf16_t*)(p.ws + WS_PB);
    for (int i0 = gw; i0 < 2 * MV; i0 += 4 * NGW) {
        f32x4 v[4]; size_t dst[4]; bool ok[4];
#pragma unroll
        for (int u = 0; u < 4; ++u) { const int i = i0 + u * NGW; ok[u] = i < 2 * MV; const int ic = ok[u] ? i : i0; const int l = ic / MV, r = ic % MV;
            const float* src = (r < MPR) ? p.in[6] + ((size_t)l * MPR + r) * PLE : p.in[7] + ((size_t)l * NSAMP + (r - MPR)) * PLE;
            v[u] = *(const f32x4*)(src + lane * 4); dst[u] = ((size_t)l * MP + r) * PLE + lane * 4; }
#pragma unroll
        for (int u = 0; u < 4; ++u) if (ok[u]) { u32x2 w; w.x = pk2(v[u][0], v[u][1]); w.y = pk2(v[u][2], v[u][3]); *(u32x2*)(PB + dst[u]) = w; }
    }
}

constexpr int H_WTOT = 0;
constexpr int H_QT = 4096;
constexpr int H_QH = H_QT + 8704;
constexpr int H_KT = H_QH + 8704;
constexpr int H_KTT = H_KT + 8704;
constexpr int H_VT = H_KTT + 10240;
constexpr int H_ST = H_VT + 10240;
constexpr int H_PS = H_ST + 34816;
constexpr int H_GD = H_PS + 2560;
constexpr int H_OSS = H_GD + 512;
constexpr int H_OT = H_OSS + 1024;
static_assert(H_OT + 8704 <= LDS_BYTES - 16, "hgrn lds");
__device__ __forceinline__ void hgrn_pass1_item(int wv, const Params& p, unsigned char* hsc, int l, int item, LAS unsigned char* lds) {
    const int c = item & 15, h = (item >> 4) & 7, b = item >> 7;
    const int tid = get_tid(wv); const int lane = tid & 63, wave = __builtin_amdgcn_readfirstlane(tid >> 6);
    bf16_t* Z = (bf16_t*)(p.ws + WS_Z); const float* LF = (const float*)(p.ws + WS_LF); bf16_t* MIX = (bf16_t*)(p.ws + WS_MIX);
    LAS float* WTOT = (LAS float*)(lds + H_WTOT); LAS float* GD = (LAS float*)(lds + H_GD); LAS float* OSS = (LAS float*)(lds + H_OSS);
    LAS bf16_t* QT = (LAS bf16_t*)(lds + H_QT); LAS bf16_t* QH = (LAS bf16_t*)(lds + H_QH); LAS bf16_t* KT = (LAS bf16_t*)(lds + H_KT);
    LAS bf16_t* KTT = (LAS bf16_t*)(lds + H_KTT); LAS bf16_t* VT = (LAS bf16_t*)(lds + H_VT); LAS bf16_t* ST = (LAS bf16_t*)(lds + H_ST); LAS bf16_t* PS = (LAS bf16_t*)(lds + H_PS);
    LAS bf16_t* OT = (LAS bf16_t*)(lds + H_OT);
    __syncthreads();
    for (int i = tid; i < 128 * 136 / 2; i += 512) ((LAS unsigned*)ST)[i] = 0u;
    f32x4 Sacc[8];
#pragma unroll
    for (int k = 0; k < 8; ++k) Sacc[k] = (f32x4){0.f, 0.f, 0.f, 0.f};
    const size_t row0 = (size_t)b * SEQ + (size_t)c * 128;
    float bsum[8] = {0.f, 0.f, 0.f, 0.f, 0.f, 0.f, 0.f, 0.f};
    u32x4 q8r, v8r; f32x4 lfa, lfb;
    { const int tt = tid >> 4, k8 = (tid & 15) * 8; const size_t r = row0 + tt; q8r = *(const u32x4*)(Z + r * DIN + ZQ + h * 128 + k8); v8r = *(const u32x4*)(Z + r * DIN + ZI + h * 128 + k8);
      lfa = *(const f32x4*)(LF + r * 1024 + h * 128 + k8); lfb = *(const f32x4*)(LF + r * 1024 + h * 128 + k8 + 4); }
    const int tt0 = tid >> 4, k80 = (tid & 15) * 8, i160 = lane & 15, q40 = lane >> 4;
    for (int j = 0; j < 4; ++j) {
        int tt = tt0, k8 = k80, i16 = i160, q4 = q40;
        asm volatile("" : "+v"(tt), "+v"(k8), "+v"(i16), "+v"(q4));
        const int vcol = h * 128 + 16 * wave + i16;
        float lf[8] = {lfa[0], lfa[1], lfa[2], lfa[3], lfb[0], lfb[1], lfb[2], lfb[3]};
        float pb[8];
#pragma unroll
        for (int i = 0; i < 8; ++i) { float x = lf[i]; float y = __shfl_up(x, 16); if (q4 >= 1) x += y; y = __shfl_up(x, 32); if (q4 >= 2) x += y; pb[i] = x; }
        if (q4 == 3) { *(LAS f32x4*)(WTOT + wave * 128 + k8) = (f32x4){pb[0], pb[1], pb[2], pb[3]}; *(LAS f32x4*)(WTOT + wave * 128 + k8 + 4) = (f32x4){pb[4], pb[5], pb[6], pb[7]}; }
        __syncthreads();
        if (j > 0) *(u32x4*)(MIX + (row0 + (size_t)(j - 1) * 32 + tt) * DM + h * 128 + k8) = *(const LAS u32x4*)(OT + tt * 136 + k8);
        float off[8], tot[8];
#pragma unroll
        for (int i = 0; i < 8; ++i) { off[i] = 0.f; tot[i] = 0.f; }
#pragma unroll
        for (int w2 = 0; w2 < 8; ++w2) { const f32x4 a = *(const LAS f32x4*)(WTOT + w2 * 128 + k8), c = *(const LAS f32x4*)(WTOT + w2 * 128 + k8 + 4);
            const float m = (w2 < wave) ? 1.f : 0.f;
#pragma unroll
            for (int i = 0; i < 4; ++i) { tot[i] += a[i]; tot[4 + i] += c[i]; off[i] += m * a[i]; off[4 + i] += m * c[i]; } }
        const unsigned qw[4] = {q8r.x, q8r.y, q8r.z, q8r.w}, vw[4] = {v8r.x, v8r.y, v8r.z, v8r.w};
        float qt[8], qh[8], kt[8];
#pragma unroll
        for (int i = 0; i < 8; ++i) {
            const float bc = pb[i] + off[i], bl = tot[i];
            const float q = (i & 1) ? hi16(qw[i >> 1]) : lo16(qw[i >> 1]);
            const float kk = 1.0f - __expf(lf[i]);
            qt[i] = q * __expf(bc); qh[i] = q * __expf(fminf(bc - bl, 80.f)); kt[i] = kk * __expf(bl - bc);
        }
        { float e[8];
#pragma unroll
          for (int i = 0; i < 8; ++i) { e[i] = qt[i] * __expf(bsum[i]); bsum[i] += tot[i]; }
          u32x4 w; w.x = pk2(e[0], e[1]); w.y = pk2(e[2], e[3]); w.z = pk2(e[4], e[5]); w.w = pk2(e[6], e[7]);
          *(u32x4*)(Z + (row0 + (size_t)j * 32 + tt) * DIN + ZQ + h * 128 + k8) = w; }
        { u32x4 w; w.x = pk2(qt[0], qt[1]); w.y = pk2(qt[2], qt[3]); w.z = pk2(qt[4], qt[5]); w.w = pk2(qt[6], qt[7]); *(LAS u32x4*)(QT + tt * 136 + k8) = w;
          w.x = pk2(qh[0], qh[1]); w.y = pk2(qh[2], qh[3]); w.z = pk2(qh[4], qh[5]); w.w = pk2(qh[6], qh[7]); *(LAS u32x4*)(QH + tt * 136 + k8) = w;
          w.x = pk2(kt[0], kt[1]); w.y = pk2(kt[2], kt[3]); w.z = pk2(kt[4], kt[5]); w.w = pk2(kt[6], kt[7]); *(LAS u32x4*)(KT + tt * 136 + k8) = w; }
#pragma unroll
        for (int i = 0; i < 8; ++i) { const int rw = swz8(k8 + i); KTT[rw * 40 + tt] = (bf16_t)f2bf(kt[i]); VT[rw * 40 + tt] = (bf16_t)((i & 1) ? (vw[i >> 1] >> 16) : (vw[i >> 1] & 0xffffu)); }
        if (tid < 16) {
#pragma unroll
            for (int i = 0; i < 8; ++i) GD[k8 + i] = __expf(tot[i]);
        }
        __syncthreads();
        if (j + 1 < 4) { const size_t r = row0 + (size_t)(j + 1) * 32 + tt; q8r = *(const u32x4*)(Z + r * DIN + ZQ + h * 128 + k8); v8r = *(const u32x4*)(Z + r * DIN + ZI + h * 128 + k8);
            lfa = *(const f32x4*)(LF + r * 1024 + h * 128 + k8); lfb = *(const f32x4*)(LF + r * 1024 + h * 128 + k8 + 4); }
        if (wave < 3) {
            const int t2 = (wave == 0) ? 0 : 1, s2 = (wave == 2) ? 1 : 0;
            f32x4 a = (f32x4){0.f, 0.f, 0.f, 0.f};
#pragma unroll
            for (int ks = 0; ks < 4; ++ks) a = MFMA16(frag((const LAS unsigned char*)KT, 136, 16 * s2 + i16, 32 * ks + 8 * q4), frag((const LAS unsigned char*)QH, 136, 16 * t2 + i16, 32 * ks + 8 * q4), a);
            const int t = 16 * t2 + i16, s = 16 * s2 + 4 * q4;
            u32x2 w; w.x = pk2(s <= t ? a[0] : 0.f, s + 1 <= t ? a[1] : 0.f); w.y = pk2(s + 2 <= t ? a[2] : 0.f, s + 3 <= t ? a[3] : 0.f);
            *(LAS u32x2*)(PS + t * 40 + s) = w;
        } else if (wave == 3) { u32x2 w; w.x = 0u; w.y = 0u; *(LAS u32x2*)(PS + i16 * 40 + 16 + 4 * q4) = w; }
        f32x4 ao[2] = {(f32x4){0.f, 0.f, 0.f, 0.f}, (f32x4){0.f, 0.f, 0.f, 0.f}};
#pragma unroll
        for (int ks = 0; ks < 4; ++ks) { const bf16x8 bs = frag((const LAS unsigned char*)ST, 136, 16 * wave + i16, 32 * ks + 8 * q4);
#pragma unroll
            for (int t2 = 0; t2 < 2; ++t2) ao[t2] = MFMA16(frag((const LAS unsigned char*)QT, 136, 16 * t2 + i16, 32 * ks + 8 * q4), bs, ao[t2]); }
        __syncthreads();
        const bf16x8 bv = frag((const LAS unsigned char*)VT, 40, swz8(16 * wave + i16), 8 * q4);
#pragma unroll
        for (int t2 = 0; t2 < 2; ++t2) ao[t2] = MFMA16(frag((const LAS unsigned char*)PS, 40, 16 * t2 + i16, 8 * q4), bv, ao[t2]);
#pragma unroll
        for (int kt2 = 0; kt2 < 8; ++kt2) { const f32x4 gv = *(const LAS f32x4*)(GD + 16 * kt2 + 4 * q4); Sacc[kt2] = Sacc[kt2] * gv;
            Sacc[kt2] = MFMA16(frag((const LAS unsigned char*)KTT, 40, swz8(16 * kt2 + i16), 8 * q4), bv, Sacc[kt2]);
            u32x2 w; w.x = pk2(Sacc[kt2][0], Sacc[kt2][1]); w.y = pk2(Sacc[kt2][2], Sacc[kt2][3]); *(LAS u32x2*)(ST + (16 * wave + i16) * 136 + 16 * kt2 + 4 * q4) = w; }
#pragma unroll
        for (int t2 = 0; t2 < 2; ++t2)
#pragma unroll
            for (int jj = 0; jj < 4; ++jj) OT[(16 * t2 + 4 * q4 + jj) * 136 + 16 * wave + i16] = (bf16_t)f2bf(ao[t2][jj]);
    }
    __syncthreads();
    *(u32x4*)(MIX + (row0 + (size_t)3 * 32 + tt0) * DM + h * 128 + k80) = *(const LAS u32x4*)(OT + tt0 * 136 + k80);
    float* HL = (float*)hsc + (size_t)item * 16384;
    int lane2 = lane; asm volatile("" : "+v"(lane2));
    const int i16 = lane2 & 15, q4 = lane2 >> 4;
#pragma unroll
    for (int kt2 = 0; kt2 < 8; ++kt2)
#pragma unroll
        for (int jj = 0; jj < 4; ++jj) HL[(size_t)(16 * kt2 + 4 * q4 + jj) * 128 + 16 * wave + i16] = Sacc[kt2][jj];
    if (tid < 16) { float* HG = (float*)(hsc + HL_BYTES) + (size_t)item * 128 + tid * 8;
#pragma unroll
        for (int i = 0; i < 8; ++i) HG[i] = __expf(bsum[i]); }
}
__device__ __forceinline__ void hgrn_pass2_unit(int wv, const Params& p, const unsigned char* hsc, int l, int w) {
    const int tid = get_tid(wv);
    const int seq = w >> 2, v = (w & 3) * 32 + (tid & 31), k0 = (tid >> 5) * 8;
    const float* HL = (const float*)hsc; const float* HG = (const float*)(hsc + HL_BYTES); bf16_t* HSIN = (bf16_t*)(p.ws + WS_HSIN);
    float S[8] = {0.f, 0.f, 0.f, 0.f, 0.f, 0.f, 0.f, 0.f};
    for (int cb = 0; cb < 16; cb += 4) {
        float Lv[4][8]; f32x4 g0[4], g1[4];
#pragma unroll
        for (int u = 0; u < 4; ++u) { const size_t item = (size_t)seq * 16 + cb + u;
#pragma unroll
            for (int i = 0; i < 8; ++i) Lv[u][i] = HL[item * 16384 + (size_t)(k0 + i) * 128 + v];
            g0[u] = *(const f32x4*)(HG + item * 128 + k0); g1[u] = *(const f32x4*)(HG + item * 128 + k0 + 4); }
#pragma unroll
        for (int u = 0; u < 4; ++u) { const size_t item = (size_t)seq * 16 + cb + u;
            u32x4 wv4; wv4.x = pk2(S[0], S[1]); wv4.y = pk2(S[2], S[3]); wv4.z = pk2(S[4], S[5]); wv4.w = pk2(S[6], S[7]);
            *(u32x4*)(HSIN + item * 16384 + (size_t)v * 128 + k0) = wv4;
#pragma unroll
            for (int i = 0; i < 4; ++i) { S[i] = g0[u][i] * S[i] + Lv[u][i]; S[4 + i] = g1[u][i] * S[4 + i] + Lv[u][4 + i]; } }
    }
    float* HP = p.out + O_HP + ((size_t)l * 64 + seq) * 16384;
#pragma unroll
    for (int i = 0; i < 8; ++i) HP[(size_t)(k0 + i) * 128 + v] = S[i];
}
constexpr int P3_ST = 0, P3_QT = 34816, P3_OSS = 69632, P3_OL = 73728, P3_GT = 108544;
static_assert(P3_GT + 34816 <= LDS_ST_OFF, "pass 3 lds");
__device__ __forceinline__ void hgrn_pass3_item(int wv, const Params& p, int l, int item, LAS unsigned char* lds) {
    const int tid = get_tid(wv); const int lane = tid & 63, wave = __builtin_amdgcn_readfirstlane(tid >> 6), i16 = lane & 15, q4 = lane >> 4;
    const int c = item & 15, h = (item >> 4) & 7, b = item >> 7;
    const bf16_t* Z = (const bf16_t*)(p.ws + WS_Z); bf16_t* MIX = (bf16_t*)(p.ws + WS_MIX); const bf16_t* HSIN = (const bf16_t*)(p.ws + WS_HSIN) + (size_t)item * 16384;
    LAS bf16_t* ST = (LAS bf16_t*)(lds + P3_ST); LAS bf16_t* QT = (LAS bf16_t*)(lds + P3_QT); LAS float* OSS = (LAS float*)(lds + P3_OSS);
    LAS bf16_t* OL = (LAS bf16_t*)(lds + P3_OL); LAS bf16_t* GT = (LAS bf16_t*)(lds + P3_GT);
    const size_t row0 = (size_t)b * SEQ + (size_t)c * 128;
    const int rr = tid >> 2, part = (tid & 3) * 32;
    __syncthreads();
    { u32x4 t0[4], t1[4], t2[4], t3[4];
#pragma unroll
      for (int i = 0; i < 4; ++i) { t0[i] = *(const u32x4*)(HSIN + (size_t)rr * 128 + part + 8 * i); t1[i] = *(const u32x4*)(Z + (row0 + rr) * DIN + ZQ + h * 128 + part + 8 * i);
          t2[i] = *(const u32x4*)(MIX + (row0 + rr) * DM + h * 128 + part + 8 * i); t3[i] = *(const u32x4*)(Z + (row0 + rr) * DIN + ZG + h * 128 + part + 8 * i); }
#pragma unroll
      for (int i = 0; i < 4; ++i) { *(LAS u32x4*)(ST + rr * 136 + part + 8 * i) = t0[i]; *(LAS u32x4*)(QT + rr * 136 + part + 8 * i) = t1[i];
          *(LAS u32x4*)(OL + rr * 136 + part + 8 * i) = t2[i]; *(LAS u32x4*)(GT + rr * 136 + part + 8 * i) = t3[i]; } }
    __syncthreads();
    const int vl = 16 * wave + i16;
    f32x4 ao[8];
#pragma unroll
    for (int t2 = 0; t2 < 8; ++t2) ao[t2] = (f32x4){0.f, 0.f, 0.f, 0.f};
#pragma unroll
    for (int ks = 0; ks < 4; ++ks) { const bf16x8 bs = frag((const LAS unsigned char*)ST, 136, 16 * wave + i16, 32 * ks + 8 * q4);
#pragma unroll
        for (int t2 = 0; t2 < 8; ++t2) ao[t2] = MFMA16(frag((const LAS unsigned char*)QT, 136, 16 * t2 + i16, 32 * ks + 8 * q4), bs, ao[t2]); }
#pragma unroll
    for (int t2 = 0; t2 < 8; ++t2)
#pragma unroll
        for (int jj = 0; jj < 4; ++jj) { const int t = 16 * t2 + 4 * q4 + jj;
            ao[t2][jj] += bf2f(OL[t * 136 + vl]);
            float s = ao[t2][jj] * ao[t2][jj]; s += __shfl_xor(s, 1); s += __shfl_xor(s, 2); s += __shfl_xor(s, 4); s += __shfl_xor(s, 8);
            if (i16 == 0) OSS[t * 8 + wave] = s; }
    __syncthreads();
    const float ngv = p.in[11][l * 128 + vl];
#pragma unroll
    for (int t2 = 0; t2 < 8; ++t2)
#pragma unroll
        for (int jj = 0; jj < 4; ++jj) { const int t = 16 * t2 + 4 * q4 + jj; const f32x4 pa = *(const LAS f32x4*)(OSS + t * 8), pc = *(const LAS f32x4*)(OSS + t * 8 + 4);
            const float rstd = rsqrtf((((pa[0] + pa[1]) + (pa[2] + pa[3])) + ((pc[0] + pc[1]) + (pc[2] + pc[3]))) * (1.0f / 128.0f) + EPS);
            OL[t * 136 + vl] = (bf16_t)f2bf(ao[t2][jj] * rstd * ngv * bf2f(GT[t * 136 + vl])); }
    __syncthreads();
#pragma unroll
    for (int i = 0; i < 4; ++i) *(u32x4*)(MIX + (row0 + rr) * DM + h * 128 + part + 8 * i) = *(const LAS u32x4*)(OL + rr * 136 + part + 8 * i);
}
__device__ __forceinline__ void hgrn_sample_item(int wv, const Params& p, int l, int s, LAS unsigned char* lds) {
    const int tid = get_tid(wv); const int lane = tid & 63, h = __builtin_amdgcn_readfirstlane(tid >> 6);
    const bf16_t* Z = (const bf16_t*)(p.ws + WS_Z); const float* LF = (const float*)(p.ws + WS_LF); bf16_t* MIX = (bf16_t*)(p.ws + WS_MIX);
    LAS float* FQ = (LAS float*)(lds + h * 2048);
    const size_t r = (size_t)MPR + s;
    __syncthreads();
#pragma unroll
    for (int i = 0; i < 2; ++i) { const int k = lane + 64 * i; const float lf = LF[r * 1024 + h * 128 + k];
        FQ[k] = __expf(lf); FQ[128 + k] = -expm1f(lf); FQ[256 + k] = bf2f(Z[r * DIN + ZQ + h * 128 + k]); }
    asm volatile("s_waitcnt lgkmcnt(0)" ::: "memory");
    const int hl = lane & 31, kh = lane >> 5;
    const u32x2 vw = *(const u32x2*)(Z + r * DIN + ZI + h * 128 + 4 * hl);
    const f32x4 vv = (f32x4){lo16(vw.x), hi16(vw.x), lo16(vw.y), hi16(vw.y)};
    const float* S0 = p.in[2] + (((size_t)l * NSAMP + s) * 8 + h) * 16384;
    float* S1 = p.out + O_HS + (((size_t)l * NSAMP + s) * 8 + h) * 16384;
    f32x4 o = (f32x4){0.f, 0.f, 0.f, 0.f};
    for (int kb = 0; kb < 128; kb += 32) {
        f32x4 sv[16];
#pragma unroll
        for (int u = 0; u < 16; ++u) sv[u] = *(const f32x4*)(S0 + (size_t)(kb + 2 * u + kh) * 128 + 4 * hl);
#pragma unroll
        for (int u = 0; u < 16; ++u) { const int k = kb + 2 * u + kh; const float f = FQ[k], kk = FQ[128 + k], q = FQ[256 + k];
            const f32x4 sn = sv[u] * f + vv * kk; *(f32x4*)(S1 + (size_t)k * 128 + 4 * hl) = sn; o += sn * q; }
    }
#pragma unroll
    for (int j = 0; j < 4; ++j) o[j] += __shfl_xor(o[j], 32);
    const float rstd = rsqrtf(wave_sum((o[0] * o[0] + o[1] * o[1]) + (o[2] * o[2] + o[3] * o[3])) * (0.5f / 128.0f) + EPS);
    const u32x2 gw = *(const u32x2*)(Z + r * DIN + ZG + h * 128 + 4 * hl);
    const f32x4 ng = *(const f32x4*)(p.in[11] + l * 128 + 4 * hl);
    if (kh == 0) { u32x2 w; w.x = pk2(o[0] * rstd * ng[0] * lo16(gw.x), o[1] * rstd * ng[1] * hi16(gw.x)); w.y = pk2(o[2] * rstd * ng[2] * lo16(gw.y), o[3] * rstd * ng[3] * hi16(gw.y));
        *(u32x2*)(MIX + r * DM + h * 128 + 4 * hl) = w; }
}
constexpr int SW_KN = 0;
constexpr int SW_VT = 36864;
constexpr int SW_PS = SW_VT + 33792;
static_assert(SW_PS + 8 * 8448 <= LDS_BYTES, "swa lds");
__device__ __forceinline__ void swa_prompt_item(int wv, const Params& p, int l, int item, LAS unsigned char* lds) {
    const int tid = get_tid(wv); const int lane = tid & 63, wave = __builtin_amdgcn_readfirstlane(tid >> 6), i16 = lane & 15, q4 = lane >> 4;
    const int kvh = item & 1, nb = (item >> 1) & 15, b = item >> 5;
    const bf16_t* Z = (const bf16_t*)(p.ws + WS_Z); bf16_t* MIX = (bf16_t*)(p.ws + WS_MIX);
    LAS bf16_t* KN = (LAS bf16_t*)(lds + SW_KN); LAS bf16_t* VT = (LAS bf16_t*)(lds + SW_VT); LAS bf16_t* PS = (LAS bf16_t*)(lds + SW_PS + wave * 8448);
    __syncthreads();
    {
        const int key = tid >> 1, half = tid & 1;
        const int pos = (nb - 1) * 128 + key;
        float kv[32], vv[32];
        if (pos >= 0) {
            const size_t r = (size_t)b * SEQ + pos;
#pragma unroll
            for (int i = 0; i < 4; ++i) { const u32x4 kw = *(const u32x4*)(Z + r * DIN + ZSK + kvh * 64 + 32 * half + 8 * i), vw = *(const u32x4*)(Z + r * DIN + ZSV + kvh * 64 + 32 * half + 8 * i);
                kv[8 * i + 0] = lo16(kw.x); kv[8 * i + 1] = hi16(kw.x); kv[8 * i + 2] = lo16(kw.y); kv[8 * i + 3] = hi16(kw.y); kv[8 * i + 4] = lo16(kw.z); kv[8 * i + 5] = hi16(kw.z); kv[8 * i + 6] = lo16(kw.w); kv[8 * i + 7] = hi16(kw.w);
                vv[8 * i + 0] = lo16(vw.x); vv[8 * i + 1] = hi16(vw.x); vv[8 * i + 2] = lo16(vw.y); vv[8 * i + 3] = hi16(vw.y); vv[8 * i + 4] = lo16(vw.z); vv[8 * i + 5] = hi16(vw.z); vv[8 * i + 6] = lo16(vw.w); vv[8 * i + 7] = hi16(vw.w); }
        } else {
#pragma unroll
            for (int i = 0; i < 32; ++i) { kv[i] = 0.f; vv[i] = 0.f; }
        }
        float ss = 0.f;
#pragma unroll
        for (int i = 0; i < 32; ++i) ss += kv[i] * kv[i];
        ss += __shfl_xor(ss, 1);
        const float rstd = rsqrtf(ss * (1.0f / 64.0f) + EPS);
        const float* kg = p.in[13] + l * 64 + 32 * half;
#pragma unroll
        for (int i = 0; i < 32; ++i) kv[i] = kv[i] * rstd * kg[i];
#pragma unroll
        for (int i = 0; i < 4; ++i) { u32x4 w; w.x = pk2(kv[8 * i], kv[8 * i + 1]); w.y = pk2(kv[8 * i + 2], kv[8 * i + 3]); w.z = pk2(kv[8 * i + 4], kv[8 * i + 5]); w.w = pk2(kv[8 * i + 6], kv[8 * i + 7]);
            *(LAS u32x4*)(KN + key * 72 + 32 * half + 8 * i) = w; }
#pragma unroll
        for (int i = 0; i < 32; ++i) VT[(32 * half + i) * 264 + key] = (bf16_t)f2bf(vv[i]);
        if (nb == 15 && key >= 128) {
            float* kd = p.out + O_KP + ((((size_t)l * 8 + b) * 128 + (key - 128)) * 2 + kvh) * 64 + 32 * half;
            float* vd = p.out + O_VP + ((((size_t)l * 8 + b) * 128 + (key - 128)) * 2 + kvh) * 64 + 32 * half;
#pragma unroll
            for (int i = 0; i < 8; ++i) { *(f32x4*)(kd + 4 * i) = (f32x4){kv[4 * i], kv[4 * i + 1], kv[4 * i + 2], kv[4 * i + 3]}; *(f32x4*)(vd + 4 * i) = (f32x4){vv[4 * i], vv[4 * i + 1], vv[4 * i + 2], vv[4 * i + 3]}; }
        }
    }
    __syncthreads();
    const int g = wave >> 1, ph = wave & 1, hq = kvh * 4 + g;
    const float sink = p.in[14][l * 8 + hq];
    u32x4 qraw[4][2];
#pragma unroll
    for (int mt = 0; mt < 4; ++mt) { const size_t rq = (size_t)b * SEQ + nb * 128 + 64 * ph + 16 * mt + i16;
        qraw[mt][0] = *(const u32x4*)(Z + rq * DIN + ZSQ + hq * 64 + 8 * q4); qraw[mt][1] = *(const u32x4*)(Z + rq * DIN + ZSQ + hq * 64 + 32 + 8 * q4); }
#pragma unroll
    for (int mt = 0; mt < 4; ++mt) {
        const int qi = 64 * ph + 16 * mt + i16;
        bf16x8 qf[2];
        {
            const u32x4 w0 = qraw[mt][0], w1 = qraw[mt][1];
            float a[16] = {lo16(w0.x), hi16(w0.x), lo16(w0.y), hi16(w0.y), lo16(w0.z), hi16(w0.z), lo16(w0.w), hi16(w0.w), lo16(w1.x), hi16(w1.x), lo16(w1.y), hi16(w1.y), lo16(w1.z), hi16(w1.z), lo16(w1.w), hi16(w1.w)};
            float ss = 0.f;
#pragma unroll
            for (int i = 0; i < 16; ++i) ss += a[i] * a[i];
            ss += __shfl_xor(ss, 16); ss += __shfl_xor(ss, 32);
            const float sc = rsqrtf(ss * (1.0f / 64.0f) + EPS) * 0.125f;
            const float* qg = p.in[12] + l * 64;
#pragma unroll
            for (int i = 0; i < 8; ++i) { a[i] *= sc * qg[8 * q4 + i]; a[8 + i] *= sc * qg[32 + 8 * q4 + i]; }
            u32x4 f0, f1; f0.x = pk2(a[0], a[1]); f0.y = pk2(a[2], a[3]); f0.z = pk2(a[4], a[5]); f0.w = pk2(a[6], a[7]); f1.x = pk2(a[8], a[9]); f1.y = pk2(a[10], a[11]); f1.z = pk2(a[12], a[13]); f1.w = pk2(a[14], a[15]);
            qf[0] = __builtin_bit_cast(bf16x8, f0); qf[1] = __builtin_bit_cast(bf16x8, f1);
        }
        f32x4 sc_[16];
        float mx = -3.0e38f;
#pragma unroll
        for (int kt = 0; kt < 16; ++kt) { f32x4 a = (f32x4){0.f, 0.f, 0.f, 0.f};
            a = MFMA16(frag((const LAS unsigned char*)KN, 72, 16 * kt + i16, 8 * q4), qf[0], a);
            a = MFMA16(frag((const LAS unsigned char*)KN, 72, 16 * kt + i16, 32 + 8 * q4), qf[1], a);
#pragma unroll
            for (int jj = 0; jj < 4; ++jj) { const int kj = 16 * kt + 4 * q4 + jj; const bool ok = (kj > qi) && (kj <= qi + 128) && (nb > 0 || kj >= 128);
                a[jj] = ok ? a[jj] : -3.0e38f; mx = fmaxf(mx, a[jj]); }
            sc_[kt] = a; }
        mx = fmaxf(mx, __shfl_xor(mx, 16)); mx = fmaxf(mx, __shfl_xor(mx, 32)); mx = fmaxf(mx, sink);
        float sum = 0.f;
#pragma unroll
        for (int kt = 0; kt < 16; ++kt)
#pragma unroll
            for (int jj = 0; jj < 4; ++jj) { const float e = (sc_[kt][jj] > -1.0e38f) ? __expf(sc_[kt][jj] - mx) : 0.f; sc_[kt][jj] = e; sum += e; }
        sum += __shfl_xor(sum, 16); sum += __shfl_xor(sum, 32);
        const float inv = 1.0f / (sum + __expf(sink - mx));
#pragma unroll
        for (int kt = 0; kt < 16; ++kt) { u32x2 w; w.x = pk2(sc_[kt][0] * inv, sc_[kt][1] * inv); w.y = pk2(sc_[kt][2] * inv, sc_[kt][3] * inv); *(LAS u32x2*)(PS + i16 * 264 + 16 * kt + 4 * q4) = w; }
        asm volatile("s_waitcnt lgkmcnt(0)" ::: "memory");
        f32x4 ao[4];
#pragma unroll
        for (int dt = 0; dt < 4; ++dt) ao[dt] = (f32x4){0.f, 0.f, 0.f, 0.f};
#pragma unroll
        for (int ks = 0; ks < 8; ++ks) { const bf16x8 pa = frag((const LAS unsigned char*)PS, 264, i16, 32 * ks + 8 * q4);
#pragma unroll
            for (int dt = 0; dt < 4; ++dt) ao[dt] = MFMA16(pa, frag((const LAS unsigned char*)VT, 264, 16 * dt + i16, 32 * ks + 8 * q4), ao[dt]); }
        asm volatile("s_waitcnt lgkmcnt(0)" ::: "memory");
#pragma unroll
        for (int dt = 0; dt < 4; ++dt)
#pragma unroll
            for (int jj = 0; jj < 4; ++jj) { const size_t ro = (size_t)b * SEQ + nb * 128 + 64 * ph + 16 * mt + 4 * q4 + jj;
                MIX[ro * DM + 1024 + hq * 64 + 16 * dt + i16] = (bf16_t)f2bf(ao[dt][jj]); }
    }
}
constexpr int SD_KL = 0;
constexpr int SD_VL = 66560;
constexpr int SD_QN = 133120;
constexpr int SD_KV = SD_QN + 2048;
constexpr int SD_PL = SD_KV + 1024;
static_assert(SD_PL + 4096 <= LDS_BYTES, "swa dec lds");
__device__ __forceinline__ void swa_sample_item(int wv, const Params& p, int l, int s, LAS unsigned char* lds) {
    const int tid = get_tid(wv); const int lane = tid & 63, wave = __builtin_amdgcn_readfirstlane(tid >> 6);
    const bf16_t* Z = (const bf16_t*)(p.ws + WS_Z); bf16_t* MIX = (bf16_t*)(p.ws + WS_MIX);
    LAS float* KL = (LAS float*)(lds + SD_KL); LAS float* VL = (LAS float*)(lds + SD_VL); LAS float* QN = (LAS float*)(lds + SD_QN);
    LAS float* KVN = (LAS float*)(lds + SD_KV); LAS float* PL = (LAS float*)(lds + SD_PL);
    const size_t r = (size_t)MPR + s;
    __syncthreads();
    { const float q = bf2f(Z[r * DIN + ZSQ + wave * 64 + lane]); const float rstd = rsqrtf(wave_sum(q * q) * (1.0f / 64.0f) + EPS); QN[wave * 64 + lane] = q * rstd * p.in[12][l * 64 + lane] * 0.125f; }
    if (wave < 2) { const float k = bf2f(Z[r * DIN + ZSK + wave * 64 + lane]); const float rstd = rsqrtf(wave_sum(k * k) * (1.0f / 64.0f) + EPS);
        KVN[wave * 64 + lane] = k * rstd * p.in[13][l * 64 + lane]; KVN[128 + wave * 64 + lane] = bf2f(Z[r * DIN + ZSV + wave * 64 + lane]); }
    __syncthreads();
    const float* ck = p.in[3] + ((size_t)l * NSAMP + s) * 128 * 128; const float* cv = p.in[4] + ((size_t)l * NSAMP + s) * 128 * 128;
    float* ko = p.out + O_KS + ((size_t)l * NSAMP + s) * 128 * 128; float* vo = p.out + O_VS + ((size_t)l * NSAMP + s) * 128 * 128;
    for (int base = 0; base < 16384; base += 8 * 512) {
        float kx[8], vx[8];
#pragma unroll
        for (int u = 0; u < 8; ++u) { const int idx = base + u * 512 + tid, i = idx >> 7, rem = idx & 127;
            kx[u] = (i < 127) ? ck[(i + 1) * 128 + rem] : KVN[rem]; vx[u] = (i < 127) ? cv[(i + 1) * 128 + rem] : KVN[128 + rem]; }
#pragma unroll
        for (int u = 0; u < 8; ++u) { const int idx = base + u * 512 + tid, i = idx >> 7, rem = idx & 127, kvh = rem >> 6, d = rem & 63;
            ko[idx] = kx[u]; vo[idx] = vx[u]; KL[(kvh * 128 + i) * 65 + d] = kx[u]; VL[(kvh * 128 + i) * 65 + d] = vx[u]; }
    }
    __syncthreads();
    const int hq = wave, kvh = hq >> 2;
    const float sink = p.in[14][l * 8 + hq];
    float s0 = 0.f, s1 = 0.f;
#pragma unroll 8
    for (int d = 0; d < 64; ++d) { const float q = QN[hq * 64 + d]; s0 += q * KL[(kvh * 128 + lane) * 65 + d]; s1 += q * KL[(kvh * 128 + 64 + lane) * 65 + d]; }
    const float mx = fmaxf(wave_max(fmaxf(s0, s1)), sink);
    const float e0 = __expf(s0 - mx), e1 = __expf(s1 - mx);
    const float inv = 1.0f / (wave_sum(e0 + e1) + __expf(sink - mx));
    PL[hq * 128 + lane] = e0 * inv; PL[hq * 128 + 64 + lane] = e1 * inv;
    asm volatile("s_waitcnt lgkmcnt(0)" ::: "memory");
    float o = 0.f;
#pragma unroll 8
    for (int i = 0; i < 128; ++i) o += PL[hq * 128 + i] * VL[(kvh * 128 + i) * 65 + lane];
    MIX[r * DM + 1024 + hq * 64 + lane] = (bf16_t)f2bf(o);
}
constexpr int GM_WL = 0;
constexpr int GM_VN = 34816;
constexpr int GM_ST = 69632;
static_assert(GM_ST + 1024 <= LDS_BYTES, "gmlp lds");
__device__ __forceinline__ void gmlp_prompt_item(int wv, const Params& p, int l, int item, LAS unsigned char* lds) {
    const int tid = get_tid(wv); const int lane = tid & 63, wave = __builtin_amdgcn_readfirstlane(tid >> 6), i16 = lane & 15, q4 = lane >> 4;
    const bf16_t* Z = (const bf16_t*)(p.ws + WS_Z); bf16_t* MIX = (bf16_t*)(p.ws + WS_MIX);
    LAS bf16_t* WL = (LAS bf16_t*)(lds + GM_WL); LAS bf16_t* VN = (LAS bf16_t*)(lds + GM_VN); LAS float* STAT = (LAS float*)(lds + GM_ST);
    const size_t r0 = (size_t)item * 128;
    __syncthreads();
    for (int i = 0; i < 16; ++i) { const int q = 16 * wave + i; const u32x4 w = *(const u32x4*)(Z + (r0 + q) * DIN + ZVR + 8 * lane);
        const float a[8] = {lo16(w.x), hi16(w.x), lo16(w.y), hi16(w.y), lo16(w.z), hi16(w.z), lo16(w.w), hi16(w.w)};
        float s = 0.f, s2 = 0.f;
#pragma unroll
        for (int k = 0; k < 8; ++k) { s += a[k]; s2 += a[k] * a[k]; }
        s = wave_sum(s); s2 = wave_sum(s2);
        const float mean = s * (1.0f / 512.0f), var = fmaxf(s2 * (1.0f / 512.0f) - mean * mean, 0.f);
        if (lane == 0) { STAT[q] = mean; STAT[128 + q] = rsqrtf(var + EPS); } }
    for (int g = 0; g < 4; ++g) {
        __syncthreads();
        {
            const int pr = tid >> 2, qq = (tid & 3) * 32;
            const float* wsrc = p.in[17] + (((size_t)l * 4 + g) * 128 + pr) * 128 + qq;
#pragma unroll
            for (int i = 0; i < 4; ++i) { const f32x4 a = *(const f32x4*)(wsrc + 8 * i), c = *(const f32x4*)(wsrc + 8 * i + 4); const int q0 = qq + 8 * i;
                u32x4 w; w.x = pk2(q0 <= pr ? a[0] : 0.f, q0 + 1 <= pr ? a[1] : 0.f); w.y = pk2(q0 + 2 <= pr ? a[2] : 0.f, q0 + 3 <= pr ? a[3] : 0.f);
                w.z = pk2(q0 + 4 <= pr ? c[0] : 0.f, q0 + 5 <= pr ? c[1] : 0.f); w.w = pk2(q0 + 6 <= pr ? c[2] : 0.f, q0 + 7 <= pr ? c[3] : 0.f);
                *(LAS u32x4*)(WL + pr * 136 + q0) = w; }
            const int q = tid >> 2, cc = (tid & 3) * 32;
            const float mean = STAT[q], rstd = STAT[128 + q];
            const float* lg = p.in[15] + l * 512 + g * 128 + cc; const float* lbb = p.in[16] + l * 512 + g * 128 + cc;
#pragma unroll
            for (int i = 0; i < 4; ++i) { const u32x4 w = *(const u32x4*)(Z + (r0 + q) * DIN + ZVR + g * 128 + cc + 8 * i);
                const float a[8] = {lo16(w.x), hi16(w.x), lo16(w.y), hi16(w.y), lo16(w.z), hi16(w.z), lo16(w.w), hi16(w.w)};
#pragma unroll
                for (int k = 0; k < 8; ++k) VN[(cc + 8 * i + k) * 136 + q] = (bf16_t)f2bf((a[k] - mean) * rstd * lg[8 * i + k] + lbb[8 * i + k]); }
        }
        __syncthreads();
        f32x4 acc[8];
#pragma unroll
        for (int ct = 0; ct < 8; ++ct) acc[ct] = (f32x4){0.f, 0.f, 0.f, 0.f};
        const int ksmax = (16 * wave + 15) >> 5;
        for (int ks = 0; ks <= ksmax; ++ks) { const bf16x8 wb = frag((const LAS unsigned char*)WL, 136, 16 * wave + i16, 32 * ks + 8 * q4);
#pragma unroll
            for (int ct = 0; ct < 8; ++ct) acc[ct] = MFMA16(frag((const LAS unsigned char*)VN, 136, 16 * ct + i16, 32 * ks + 8 * q4), wb, acc[ct]); }
        const int pr = 16 * wave + i16;
        const float bsv = p.in[18][((size_t)l * 4 + g) * 128 + pr];
        u32x2 uwv[8];
#pragma unroll
        for (int ct = 0; ct < 8; ++ct) uwv[ct] = *(const u32x2*)(Z + (r0 + pr) * DIN + ZU + g * 128 + 16 * ct + 4 * q4);
#pragma unroll
        for (int ct = 0; ct < 8; ++ct) { const int c = g * 128 + 16 * ct + 4 * q4;
            const u32x2 uw = uwv[ct];
            u32x2 w; w.x = pk2(lo16(uw.x) * (acc[ct][0] + bsv), hi16(uw.x) * (acc[ct][1] + bsv)); w.y = pk2(lo16(uw.y) * (acc[ct][2] + bsv), hi16(uw.y) * (acc[ct][3] + bsv));
            *(u32x2*)(MIX + (r0 + pr) * DM + 1536 + c) = w; }
    }
}
__device__ __forceinline__ void gmlp_sample_item(int wv, const Params& p, int l, int item) {
    const int tid = get_tid(wv); const int lane = tid & 63, wave = __builtin_amdgcn_readfirstlane(tid >> 6);
    const bf16_t* Z = (const bf16_t*)(p.ws + WS_Z); bf16_t* MIX = (bf16_t*)(p.ws + WS_MIX);
    const int s = item * 8 + wave; const size_t r = (size_t)MPR + s;
    const u32x4 w = *(const u32x4*)(Z + r * DIN + ZVR + 8 * lane), uw = *(const u32x4*)(Z + r * DIN + ZU + 8 * lane);
    const float a[8] = {lo16(w.x), hi16(w.x), lo16(w.y), hi16(w.y), lo16(w.z), hi16(w.z), lo16(w.w), hi16(w.w)};
    const float uu[8] = {lo16(uw.x), hi16(uw.x), lo16(uw.y), hi16(uw.y), lo16(uw.z), hi16(uw.z), lo16(uw.w), hi16(uw.w)};
    float sm = 0.f, s2 = 0.f;
#pragma unroll
    for (int k = 0; k < 8; ++k) { sm += a[k]; s2 += a[k] * a[k]; }
    sm = wave_sum(sm); s2 = wave_sum(s2);
    const float mean = sm * (1.0f / 512.0f), rstd = rsqrtf(fmaxf(s2 * (1.0f / 512.0f) - mean * mean, 0.f) + EPS);
    const int g = lane >> 4;
    const float w00 = p.in[17][((size_t)l * 4 + g) * 16384], b0 = p.in[18][((size_t)l * 4 + g) * 128];
    float vn[8], o[8];
#pragma unroll
    for (int k = 0; k < 8; ++k) { vn[k] = (a[k] - mean) * rstd * p.in[15][l * 512 + 8 * lane + k] + p.in[16][l * 512 + 8 * lane + k]; o[k] = uu[k] * (w00 * vn[k] + b0); }
    float* gs = p.out + O_GS + ((size_t)l * NSAMP + s) * 512 + 8 * lane;
    *(f32x4*)gs = (f32x4){vn[0], vn[1], vn[2], vn[3]}; *(f32x4*)(gs + 4) = (f32x4){vn[4], vn[5], vn[6], vn[7]};
    u32x4 ow; ow.x = pk2(o[0], o[1]); ow.y = pk2(o[2], o[3]); ow.z = pk2(o[4], o[5]); ow.w = pk2(o[6], o[7]);
    *(u32x4*)(MIX + r * DM + 1536 + 8 * lane) = ow;
}
__device__ __forceinline__ void mixer_other(int wv, const Params& p, int l, int it, LAS unsigned char* lds) {
#ifndef MXM
#define MXM 0xff
#endif
    if (it < 256) { if (MXM & 1) swa_prompt_item(wv, p, l, it, lds); }
    else if (it < 384) { if (MXM & 2) gmlp_prompt_item(wv, p, l, it - 256, lds); }
    else if (it < 512) { if (MXM & 4) hgrn_sample_item(wv, p, l, it - 384, lds); }
    else if (it < 528) { if (MXM & 16) gmlp_sample_item(wv, p, l, it - 512); }
    else if (it < 640) { }
    else { if (MXM & 8) swa_sample_item(wv, p, l, it - 640, lds); }
}
__device__ __forceinline__ void phase_mixers(int wv, const Params& p, unsigned char* hsc, int l, LAS unsigned char* lds) {
    const int G = gridDim.x, bid = blockIdx.x;
    constexpr int NOTHER = 768;
    for (int it = bid; it < 1024 + NOTHER; it += G) {
        if (it < 1024) hgrn_pass1_item(wv, p, hsc, l, it, lds);
        else mixer_other(wv, p, l, it - 1024, lds);
    }
}
__device__ __forceinline__ void phase_hgrn2(int wv, const Params& p, const unsigned char* hsc, int l) {
    for (int w = blockIdx.x; w < 256; w += gridDim.x) hgrn_pass2_unit(wv, p, hsc, l, w);
}
__device__ __forceinline__ void phase_hgrn3(int wv, const Params& p, int l, LAS unsigned char* lds) {
    for (int it = blockIdx.x; it < 1024; it += gridDim.x) hgrn_pass3_item(wv, p, l, it, lds);
}
__device__ __forceinline__ void phase_fixup(int wv, const Params& p, int l) {
    const bf16_t* SIDE = (const bf16_t*)(p.ws + WS_SIDE); bf16_t* ACT = (bf16_t*)(p.ws + WS_ACT);
    const float* cw = p.in[22] + (size_t)l * 3 * DFF2; const float* cb = p.in[23] + (size_t)l * DFF2;
    const int NT = gridDim.x * 512;
    constexpr int CG8 = DFF / 8;
    const int ftid = get_tid(wv);
    for (int i = blockIdx.x * 512 + ftid; i < 256 * 2 * CG8; i += NT) {
        const int c = (i % CG8) * 8, sr = i / CG8, rho = sr & 1, s = sr >> 1;
        const int r = 64 * s + rho; const bool first = (s & 31) == 0;
        const bf16_t* cur = SIDE + ((size_t)s * 4 + 2 + rho) * DFF2;
        const bf16_t* p1 = rho ? SIDE + ((size_t)s * 4 + 2) * DFF2 : SIDE + ((size_t)(s - 1) * 4 + 1) * DFF2;
        const bf16_t* p2 = rho ? SIDE + ((size_t)(s - 1) * 4 + 1) * DFF2 : SIDE + ((size_t)(s - 1) * 4 + 0) * DFF2;
        const bool z1 = first && rho == 0, z2 = first;
        float o[8];
#pragma unroll
        for (int hv = 0; hv < 2; ++hv) {
            const int cc = c + hv * DFF;
            const u32x4 x0 = *(const u32x4*)(cur + cc);
            u32x4 x1 = (u32x4){0u, 0u, 0u, 0u}, x2 = x1;
            if (!z1) x1 = *(const u32x4*)(p1 + cc);
            if (!z2) x2 = *(const u32x4*)(p2 + cc);
            const unsigned a0[4] = {x0.x, x0.y, x0.z, x0.w}, a1[4] = {x1.x, x1.y, x1.z, x1.w}, a2[4] = {x2.x, x2.y, x2.z, x2.w};
#pragma unroll
            for (int k = 0; k < 8; ++k) {
                const float v0 = (k & 1) ? hi16(a0[k >> 1]) : lo16(a0[k >> 1]), v1 = (k & 1) ? hi16(a1[k >> 1]) : lo16(a1[k >> 1]), v2 = (k & 1) ? hi16(a2[k >> 1]) : lo16(a2[k >> 1]);
                const float cv = cb[cc + k] + cw[cc + k] * v2 + cw[DFF2 + cc + k] * v1 + cw[2 * DFF2 + cc + k] * v0;
                o[k] = hv ? o[k] * cv : fsilu(cv);
            }
        }
        u32x4 w; w.x = pk2(o[0], o[1]); w.y = pk2(o[2], o[3]); w.z = pk2(o[4], o[5]); w.w = pk2(o[6], o[7]);
        *(u32x4*)(ACT + (size_t)r * DFF + c) = w;
    }
    float* conv_s = p.out + O_CS + (size_t)l * NSAMP * 2 * DFF2; const float* cstate = p.in[5] + (size_t)l * NSAMP * 2 * DFF2;
    for (int i = blockIdx.x * 512 + ftid; i < NSAMP * (DFF / 4); i += NT) {
        const int c = (i % (DFF / 4)) * 4, sidx = i / (DFF / 4);
        const float* st0 = cstate + (size_t)sidx * 2 * DFF2, * st1 = st0 + DFF2; float* d0 = conv_s + (size_t)sidx * 2 * DFF2, * d1 = d0 + DFF2;
        const f32x4 g2 = *(const f32x4*)(st0 + c), g1 = *(const f32x4*)(st1 + c), v2 = *(const f32x4*)(st0 + DFF + c), v1 = *(const f32x4*)(st1 + DFF + c);
        const f32x4 xg = *(const f32x4*)(d1 + c), xv = *(const f32x4*)(d1 + DFF + c);
        f32x4 o;
#pragma unroll
        for (int j = 0; j < 4; ++j) {
            const float cg_ = cb[c + j] + cw[c + j] * g2[j] + cw[DFF2 + c + j] * g1[j] + cw[2 * DFF2 + c + j] * xg[j];
            const float cv_ = cb[DFF + c + j] + cw[DFF + c + j] * v2[j] + cw[DFF2 + DFF + c + j] * v1[j] + cw[2 * DFF2 + DFF + c + j] * xv[j];
            o[j] = fsilu(cg_) * cv_;
        }
        u32x2 w; w.x = pk2(o[0], o[1]); w.y = pk2(o[2], o[3]); *(u32x2*)(ACT + (size_t)(MPR + sidx) * DFF + c) = w;
        *(f32x4*)(d0 + c) = g1; *(f32x4*)(d0 + DFF + c) = v1;
    }
}

#ifndef PHM
#define PHM 0xff
#endif
#define XB_TMO      128
#define XB_XCNT(j)  (256  + 64 * (j))
#define XB_XSUB(j)  (1280 + 64 * (j))
#define XB_XGEN(j)  (2304 + 64 * (j))
#define XB_TOP      3328
#define XB_TOPGEN   3392
#define XCD_BAR_WORDS 3456
#define XB_SPIN_CAP (1u << 18)

__device__ __forceinline__ unsigned xb_ld(unsigned* p)              { return __hip_atomic_load(p, __ATOMIC_RELAXED, __HIP_MEMORY_SCOPE_AGENT); }
__device__ __forceinline__ unsigned xb_add(unsigned* p, unsigned v) { return __hip_atomic_fetch_add(p, v, __ATOMIC_RELAXED, __HIP_MEMORY_SCOPE_AGENT); }
__device__ __forceinline__ unsigned xb_xcc_id() { return (unsigned)__builtin_amdgcn_s_getreg((3 << 11) | 20) & 0xFu; }
#define XB_SPIN(cond, bar) do { unsigned _sp = 0; while (cond) { __builtin_amdgcn_s_sleep(1); \
    if ((++_sp & 255u) == 0u) { if (xb_ld(&(bar)[XB_TMO])) break; if (_sp > XB_SPIN_CAP) { atomicAdd(&(bar)[XB_TMO], 1u); break; } } } } while (0)

struct XcdBarrier {
    unsigned* bar; unsigned x;
    volatile LAS unsigned* st;
};

__device__ __forceinline__ XcdBarrier xcd_barrier_post(unsigned* bar, volatile LAS unsigned* st) {
    XcdBarrier b; b.bar = bar; b.x = xb_xcc_id(); b.st = st;
    if (threadIdx.x == 0) (void)xb_add(&bar[XB_XCNT(b.x)], 1u);
    return b;
}
__device__ __forceinline__ void xcd_barrier_complete(unsigned* bar, unsigned x, unsigned& nloc, unsigned& nx) {
    const unsigned G = gridDim.x * gridDim.y * gridDim.z;
    unsigned sum, cnt, mine, sp = 0u;
    for (;;) {
        sum = 0u; cnt = 0u; mine = 0u;
#pragma unroll
        for (unsigned j = 0; j < 16; ++j) { const unsigned c = xb_ld(&bar[XB_XCNT(j)]); sum += c; cnt += (c > 0u) ? 1u : 0u; mine = (j == x) ? c : mine; }
        if (sum == G) break;
        __builtin_amdgcn_s_sleep(1);
        if ((++sp & 255u) == 0u) { if (xb_ld(&bar[XB_TMO])) break; if (sp > XB_SPIN_CAP) { atomicAdd(&bar[XB_TMO], 1u); break; } }
    }
    nloc = mine > 0u ? mine : 1u; nx = cnt > 0u ? cnt : 1u;
}

__device__ __forceinline__ void xcd_barrier(const XcdBarrier& b) {
    asm volatile("s_waitcnt vmcnt(0)" ::: "memory");
    __syncthreads();
    if (threadIdx.x == 0) {
        unsigned* bar = b.bar;
        __builtin_amdgcn_s_waitcnt(0);
        unsigned nloc = b.st[0], nx = b.st[1];
        if (nloc == 0u) { xcd_barrier_complete(bar, b.x, nloc, nx); b.st[0] = nloc; b.st[1] = nx; }
        const unsigned old = xb_add(&bar[XB_XSUB(b.x)], 1u);
        const unsigned gen = old / nloc;
        if (old + 1u == (gen + 1u) * nloc) {
            __builtin_amdgcn_fence(__ATOMIC_RELEASE, "agent");
            asm volatile("s_waitcnt vmcnt(0)" ::: "memory");
            const unsigned og = xb_add(&bar[XB_TOP], 1u);
            const unsigned tg = og / nx;
            if (og + 1u == (tg + 1u) * nx) xb_add(&bar[XB_TOPGEN], 1u);
            else XB_SPIN(xb_ld(&bar[XB_TOPGEN]) == tg, bar);
            __builtin_amdgcn_fence(__ATOMIC_ACQUIRE, "agent");
            xb_add(&bar[XB_XGEN(b.x)], 1u);
            asm volatile("s_waitcnt vmcnt(0)" ::: "memory");
        } else {
            XB_SPIN(xb_ld(&bar[XB_XGEN(b.x)]) == gen, bar);
            __builtin_amdgcn_fence(__ATOMIC_ACQUIRE, "agent");
            asm volatile("s_waitcnt vmcnt(0)" ::: "memory");
        }
    }
    __syncthreads();
}
__device__ __forceinline__ void gsync(cg::grid_group& grid) {
    asm volatile("s_waitcnt vmcnt(0) lgkmcnt(0)" ::: "memory");
    grid.sync();
    __builtin_amdgcn_fence(__ATOMIC_ACQUIRE, "agent");
    asm volatile("s_waitcnt vmcnt(0)" ::: "memory");
}
template <int l>
__device__ __forceinline__ void layer_body(int wv, const Params& p, LAS unsigned char* lds, const XcdBarrier& xbar) {
    const int G = gridDim.x, bid = blockIdx.x;
    u64* RS = (u64*)(p.ws + WS_RS); const float* LBS = (const float*)(p.ws + WS_LBS);
    bf16_t* WT = (bf16_t*)(p.ws + WS_WT);
    bf16_t* XB0p = (bf16_t*)(p.ws + WS_XB0); bf16_t* XB1p = (bf16_t*)(p.ws + WS_XB1);
    bf16_t* PB = (bf16_t*)(p.ws + WS_PB); bf16_t* Z = (bf16_t*)(p.ws + WS_Z); float* LF = (float*)(p.ws + WS_LF); bf16_t* MIX = (bf16_t*)(p.ws + WS_MIX);
    bf16_t* ACT = (bf16_t*)(p.ws + WS_ACT); bf16_t* SIDE = (bf16_t*)(p.ws + WS_SIDE);
    float* X = p.out + O_Y;
        const bf16_t* wl = WT + (size_t)l * WT_LAYER;
        bf16_t* xa = (l & 1) ? XB1p : XB0p; bf16_t* xb = (l & 1) ? XB0p : XB1p;
        pg8::StaticOrder S;
        if (PHM & 2) {
            pg8::Gemm g{xa, wl + WT_IN, DM, DM, MPR / 256, DIN / 256}; S.init(g.nM, g.nN, G, bid);
            EpiIn E{Z, LF, RS + (size_t)(3 * l) * MP, LBS + l * 1024};
            pg8::gemm_phase<EpiIn>(wv, lds, g, S, E);
            SkIn E2{Z, LF, RS + (size_t)(3 * l) * MP, LBS + l * 1024};
            { const int rem = (g.nM * g.nN) % G; const int nslack = (rem != 0 && (G - rem) * 4 >= DIN / 32) ? G - rem : 0;
              skinny_phase<2, SkIn>(wv, lds, xa + (size_t)MPR * DM, DM, wl + WT_IN, DM, DIN / 32, E2, nslack); }
        }
        xcd_barrier(xbar);
        if (PHM & 4) { phase_mixers(wv, p, (unsigned char*)xb, l, lds); xcd_barrier(xbar); phase_hgrn2(wv, p, (const unsigned char*)xb, l); xcd_barrier(xbar); phase_hgrn3(wv, p, l, lds); }
        xcd_barrier(xbar);
        if (PHM & 8) {
            pg8::Gemm g{MIX, wl + WT_OUT, DM, DM, MPR / 256, DM / 256}; S.init(g.nM, g.nN, G, bid);
            EpiRes E{xa, xb, RS + (size_t)(3 * l + 1) * MP};
            pg8::gemm_phase<EpiRes>(wv, lds, g, S, E);
            SkRes E2{xa, xb, RS + (size_t)(3 * l + 1) * MP};
            skinny_phase<1, SkRes>(wv, lds, MIX + (size_t)MPR * DM, DM, wl + WT_OUT, DM, DM / 16, E2);
        }
        xcd_barrier(xbar);
        if (PHM & 16) {
            pg8::Gemm g{xb, wl + WT_UP, DM, DM, MPR / 256, DFF2 / 256}; S.init(g.nM, g.nN, G, bid);
            EpiUp E{ACT, SIDE, RS + (size_t)(3 * l + 1) * MP, p.in[22] + (size_t)l * 3 * DFF2, p.in[23] + (size_t)l * DFF2,
                    p.out + O_CP + (size_t)l * 8 * 2 * DFF2, p.out + O_CS + (size_t)l * NSAMP * 2 * DFF2};
            pg8::gemm_phase<EpiUp>(wv, lds, g, S, E);
            SkUp E2{RS + (size_t)(3 * l + 1) * MP, p.out + O_CS + (size_t)l * NSAMP * 2 * DFF2};
            skinny_phase<4, SkUp>(wv, lds, xb + (size_t)MPR * DM, DM, wl + WT_UP, DM, DFF2 / 64, E2);
        }
        xcd_barrier(xbar);
        if (PHM & 32) {
            phase_fixup(wv, p, l);
            pg8::Gemm g{PB + (size_t)l * MP * PLE, wl + WT_PROJ, PLE, PLE, MPR / 256, DM / 256}; S.init(g.nM, g.nN, G, bid);
            EpiProj E{(bf16_t*)(p.ws + WS_LF)};
            pg8::gemm_phase<EpiProj>(wv, lds, g, S, E);
            SkProj E2{(bf16_t*)(p.ws + WS_LF)};
            skinny_phase<1, SkProj>(wv, lds, PB + ((size_t)l * MP + MPR) * PLE, PLE, wl + WT_PROJ, PLE, DM / 16, E2);
        }
        xcd_barrier(xbar);
        if (PHM & 64) {
            pg8::Gemm g{ACT, wl + WT_DOWN, DFF, DFF, MPR / 256, DM / 256}; S.init(g.nM, g.nN, G, bid);
            EpiRes E{xb, xa, RS + (size_t)(3 * l + 2) * MP};
            pg8::gemm_phase<EpiRes>(wv, lds, g, S, E);
            SkRes E2{xb, xa, RS + (size_t)(3 * l + 2) * MP};
            skinny_phase<1, SkRes>(wv, lds, ACT + (size_t)MPR * DFF, DFF, wl + WT_DOWN, DFF, DM / 16, E2);
        }
        xcd_barrier(xbar);
        if (PHM & 128) {
            pg8::Gemm g{xa, wl + WT_GATE, DM, DM, MPR / 256, DM / 256}; S.init(g.nM, g.nN, G, bid);
            EpiGate E{xa, (const bf16_t*)(p.ws + WS_LF), xb, l == 1 ? X : nullptr, RS + (size_t)(3 * l + 2) * MP, RS + (size_t)(3 * l + 3) * MP};
            pg8::gemm_phase<EpiGate>(wv, lds, g, S, E);
            SkGate E2{xa, (const bf16_t*)(p.ws + WS_LF), xb, l == 1 ? X : nullptr, RS + (size_t)(3 * l + 2) * MP, RS + (size_t)(3 * l + 3) * MP};
            skinny_phase<1, SkGate>(wv, lds, xa + (size_t)MPR * DM, DM, wl + WT_GATE, DM, DM / 16, E2);
        }
}
__global__ void __launch_bounds__(512, 2) mega_fwd(Params p) {
    extern __shared__ __attribute__((aligned(16))) unsigned char lds_raw[];
    LAS unsigned char* lds = (LAS unsigned char*)lds_raw;
    cg::grid_group grid = cg::this_grid();
    const int wv = __builtin_amdgcn_readfirstlane(threadIdx.x >> 6);
    volatile LAS unsigned* st = (volatile LAS unsigned*)(lds + LDS_ST_OFF);
    if (threadIdx.x < 4) st[threadIdx.x] = 0u;
    __syncthreads();
    const XcdBarrier xbar = xcd_barrier_post((unsigned*)(p.ws + WS_BAR), st);
    if (PHM & 1) phase_prep(wv, p, lds);
    if (gridDim.y == 0x7fff) gsync(grid);
    xcd_barrier(xbar);
#ifndef NLAYER
#define NLAYER 2
#endif
    layer_body<0>(wv, p, lds, xbar);
    if (NLAYER > 1) { xcd_barrier(xbar);
    layer_body<1>(wv, p, lds, xbar); }
}

extern "C" void kernel_launch(void* const* d_in, const int* in_sizes, int n_in, void* d_out, int out_size, void* d_ws, size_t ws_size, hipStream_t stream) {
    static int grid = 0;
    if (grid == 0) {
        if (n_in != 28 || ws_size < WS_END) { fprintf(stderr, "kernel_launch: need 28 inputs and >= %zu bytes of workspace (got %d, %zu)\n", (size_t)WS_END, n_in, ws_size); grid = -1; return; }
        int dev = 0, cus = 0, per_cu = 0;
        hipGetDevice(&dev); hipDeviceGetAttribute(&cus, hipDeviceAttributeMultiprocessorCount, dev);
        if (hipFuncSetAttribute((const void*)mega_fwd, hipFuncAttributeMaxDynamicSharedMemorySize, LDS_BYTES) != hipSuccess) { fprintf(stderr, "kernel_launch: hipFuncSetAttribute failed\n"); grid = -1; return; }
        if (hipOccupancyMaxActiveBlocksPerMultiprocessor(&per_cu, (const void*)mega_fwd, 512, LDS_BYTES) != hipSuccess || per_cu < 1) { fprintf(stderr, "kernel_launch: occupancy query says %d\n", per_cu); per_cu = 1; }
        (void)hipGetLastError();
        grid = cus * 1;
    }
    if (grid < 0) return;
    (void)hipMemsetAsync((char*)d_ws + WS_BAR, 0, XCD_BAR_WORDS * 4, stream);
    Params p{};
    for (int i = 0; i < 28; ++i) p.in[i] = (const float*)d_in[i];
    p.out = (float*)d_out; p.ws = (unsigned char*)d_ws;
    void* args[] = {&p};
    hipError_t e = hipLaunchCooperativeKernel((const void*)mega_fwd, dim3(grid), dim3(512), args, LDS_BYTES, stream);
    if (e != hipSuccess) fprintf(stderr, "cooperative launch failed: %s (grid %d)\n", hipGetErrorString(e), grid);
}
```

```cpp
#include <hip/hip_runtime.h>
#include <hip/hip_cooperative_groups.h>
#include <cstdio>
#include <cstdint>
namespace cg = cooperative_groups;

#define LAS __attribute__((address_space(3)))
typedef unsigned short bf16_t;
typedef short bf16x8 __attribute__((ext_vector_type(8)));
typedef float f32x4 __attribute__((ext_vector_type(4)));
typedef float f32x2 __attribute__((ext_vector_type(2)));
typedef unsigned u32x4 __attribute__((ext_vector_type(4)));
typedef unsigned u32x2 __attribute__((ext_vector_type(2)));

constexpr int DM = 2048, SEQ = 2048, NBATCH = 8, MPR = NBATCH * SEQ  , NSAMP = 128, MV = MPR + NSAMP  , MP = 16640  ;
constexpr int DIN = 5888, DFF = 5632, DFF2 = 11264, PLE = 256;
constexpr float EPS = 1e-6f;
constexpr float RS_SCALE = 16777216.0f;
typedef unsigned long long u64;
constexpr int ZQ = 0, ZF = 1024, ZI = 2048, ZG = 3072, ZSQ = 4096, ZSK = 4608, ZSV = 4736, ZU = 4864, ZVR = 5376;
constexpr size_t O_Y = 0;
constexpr size_t O_HP = (size_t)MV * DM;
constexpr size_t O_HS = O_HP + (size_t)2 * 8 * 8 * 16384;
constexpr size_t O_KP = O_HS + (size_t)2 * 128 * 8 * 16384;
constexpr size_t O_VP = O_KP + (size_t)2 * 8 * 128 * 128;
constexpr size_t O_KS = O_VP + (size_t)2 * 8 * 128 * 128;
constexpr size_t O_VS = O_KS + (size_t)2 * 128 * 128 * 128;
constexpr size_t O_GS = O_VS + (size_t)2 * 128 * 128 * 128;
constexpr size_t O_CP = O_GS + (size_t)2 * 128 * 512;
constexpr size_t O_CS = O_CP + (size_t)2 * 8 * 2 * DFF2;
constexpr size_t WS_RS = 0;
constexpr size_t WS_LBS = 1u << 20;
constexpr size_t WS_WT = 2u << 20;
constexpr size_t WT_IN = 0, WT_OUT = WT_IN + (size_t)DIN * DM, WT_UP = WT_OUT + (size_t)DM * DM, WT_DOWN = WT_UP + (size_t)DFF2 * DM,
                 WT_GATE = WT_DOWN + (size_t)DM * DFF, WT_PROJ = WT_GATE + (size_t)DM * DM, WT_LAYER = WT_PROJ + (size_t)DM * PLE;
constexpr size_t XB_BYTES = (size_t)MP * DM * 2;
constexpr size_t WS_XB0 = WS_WT + 2 * WT_LAYER * 2;
constexpr size_t WS_XB1 = WS_XB0 + XB_BYTES;
constexpr size_t WS_PB = WS_XB1 + XB_BYTES;
constexpr size_t WS_R = WS_PB + (size_t)2 * MP * PLE * 2;
constexpr size_t WS_Z = WS_R;
constexpr size_t WS_LF = WS_Z + (size_t)MP * DIN * 2;
constexpr size_t WS_MIX = WS_LF + (size_t)MP * 1024 * 4;
constexpr size_t WS_ACT = WS_R;
constexpr size_t WS_SIDE = WS_ACT + (size_t)MP * DFF * 2;
constexpr size_t WS_END = WS_MIX + (size_t)MP * DM * 2;
static_assert(WS_SIDE + (size_t)(MP / 64) * 4 * DFF2 * 2 <= WS_END, "side fits");
constexpr size_t HL_BYTES = (size_t)1024 * 16384 * 4;
static_assert(HL_BYTES + (size_t)1024 * 128 * 4 <= XB_BYTES, "hgrn chunk buffers fit in one XB buffer");
constexpr size_t WS_HSIN = WS_LF;
constexpr size_t WS_BAR = WS_RS + 983040;
constexpr int LDS_BYTES = 147456;
constexpr int LDS_ST_OFF = LDS_BYTES - 16;

struct Params { const float* in[28]; float* out; unsigned char* ws; };

__device__ __forceinline__ float bf2f(unsigned u16) { return __uint_as_float(u16 << 16); }
__device__ __forceinline__ unsigned f2bf(float f) { unsigned u = __float_as_uint(f); return (u + 0x7fffu + ((u >> 16) & 1u)) >> 16; }
typedef __bf16 bf16v2 __attribute__((ext_vector_type(2)));
__device__ __forceinline__ unsigned pk2(float lo, float hi) { bf16v2 v; v[0] = (__bf16)lo; v[1] = (__bf16)hi; return __builtin_bit_cast(unsigned, v); }
__device__ __forceinline__ float lo16(unsigned w) { return __uint_as_float(w << 16); }
__device__ __forceinline__ float hi16(unsigned w) { return __uint_as_float(w & 0xffff0000u); }
__device__ __forceinline__ float wave_sum(float v) {
#pragma unroll
    for (int o = 1; o < 64; o <<= 1) v += __shfl_xor(v, o);
    return v;
}
__device__ __forceinline__ float wave_max(float v) {
#pragma unroll
    for (int o = 1; o < 64; o <<= 1) v = fmaxf(v, __shfl_xor(v, o));
    return v;
}
__device__ __forceinline__ float rs_rstd(const u64* rs, int r) { return rsqrtf((float)rs[r] * (1.0f / (RS_SCALE * DM)) + EPS); }
__device__ __forceinline__ float fsigmoid(float v) { return __builtin_amdgcn_rcpf(1.0f + __expf(-v)); }
__device__ __forceinline__ float fsilu(float v) { return v * fsigmoid(v); }
__device__ __forceinline__ float fgelu(float v) { const float u = 0.7978845608f * (v + 0.044715f * v * v * v); return v * fsigmoid(2.0f * u); }
__device__ __forceinline__ float dpp_ror1(float x) { return __int_as_float(__builtin_amdgcn_update_dpp(0, __float_as_int(x), 0x121, 0xf, 0xf, false)); }
__device__ __forceinline__ float dpp_ror2(float x) { return __int_as_float(__builtin_amdgcn_update_dpp(0, __float_as_int(x), 0x122, 0xf, 0xf, false)); }
__device__ __forceinline__ float dpp_shr1(float old, float x) { return __int_as_float(__builtin_amdgcn_update_dpp(__float_as_int(old), __float_as_int(x), 0x111, 0xf, 0xf, false)); }
__device__ __forceinline__ float dpp_shr2(float old, float x) { return __int_as_float(__builtin_amdgcn_update_dpp(__float_as_int(old), __float_as_int(x), 0x112, 0xf, 0xf, false)); }
__device__ __forceinline__ bf16x8 frag(const LAS unsigned char* base, int stride_el, int row, int kofs) {
    return *(const LAS bf16x8*)(base + (size_t)(row * stride_el + kofs) * 2);
}
__device__ __forceinline__ int get_tid(int wv) { asm volatile("" : "+s"(wv)); int ln; asm volatile("v_mbcnt_lo_u32_b32 %0, -1, 0\n\tv_mbcnt_hi_u32_b32 %0, -1, %0" : "=v"(ln)); int t = wv * 64 + ln; asm volatile("" : "+v"(t)); return t; }
__device__ __forceinline__ int swz8(int k) { return k ^ ((k >> 3) & 7); }
#define MFMA16(a, b, c) __builtin_amdgcn_mfma_f32_16x16x32_bf16((a), (b), (c), 0, 0, 0)

namespace pg8 {
constexpr int BM = 256, BK = 64, HALF = 128, HTB = HALF * BK * 2, STAGE_BYTES = 8 * HTB, NXCD = 8, WGM = 4;
__device__ __forceinline__ int lds_byte(int r, int c) { const int st = (r >> 4) * 2 + (c >> 5), rr = r & 15, cc = c & 31, ob = rr * 64 + cc * 2; return st * 1024 + (ob ^ (((ob >> 9) & 1) << 5)); }
__device__ __forceinline__ void stage_rc(int b, int& R, int& C) { const int st = b / 1024, sb = b % 1024, swz = sb ^ (((sb >> 9) & 1) << 5); R = (st >> 1) * 16 + swz / 64; C = (st & 1) * 32 + (swz % 64) / 2; }
__device__ __forceinline__ int perm32(int rho) { const int n = rho >> 4, i = rho & 15; return 8 * (i >> 2) + 4 * n + (i & 3); }
struct Unit { int pm, pn; };
struct Gemm { const bf16_t* A; const bf16_t* Bt; int lda, K, nM, nN; };
struct StaticOrder {
    int nM, nN, nwg, G, c;
    __device__ __forceinline__ void init(int nM_, int nN_, int G_, int c_) { nM = nM_; nN = nN_; nwg = nM * nN; G = G_; c = c_; }
    __device__ __forceinline__ bool next(int i, Unit& u) const {
        const long L = (long)i * G + c; if (L >= nwg) return false;
        int wgid = (int)L; { const int q = nwg / NXCD, r = nwg % NXCD, xcd = wgid % NXCD, off = wgid / NXCD; wgid = (xcd < r ? xcd * (q + 1) : r * (q + 1) + (xcd - r) * q) + off; }
        const int nig = WGM * nN, gid = wgid / nig, fm = gid * WGM, gsz = (nM - fm) < WGM ? (nM - fm) : WGM;
        u.pm = fm + ((wgid % nig) % gsz); u.pn = (wgid % nig) / gsz; return true;
    }
};
template <class Epi>
__device__ __forceinline__ void gemm_phase(int wv, LAS unsigned char* lds, const Gemm g, const StaticOrder& S, const Epi& E) {
    const int tid = get_tid(wv) & 511;
    const int wid = __builtin_amdgcn_readfirstlane(tid >> 6) & 7, lane = tid & 63, wr = wid >> 2, wc = wid & 3, fr = lane & 15, fq = lane >> 4;
    const int K = g.K, nt = K / BK, lda = g.lda;
    unsigned voffA[2], voffB[2];
#pragma unroll
    for (int i = 0; i < 2; ++i) { int R, C; stage_rc(tid * 16 + i * 8192, R, C); const int Rb = (R & ~31) + perm32(R & 31);
        voffA[i] = (unsigned)(R * lda + C) * 2u; voffB[i] = (unsigned)(Rb * K + C) * 2u; }
    const size_t kstep = (size_t)(BK * 2);
    const size_t hstepA = (size_t)HALF * lda * 2, hstepB = (size_t)HALF * K * 2;
    const size_t tstepA = 2 * hstepA, tstepB = 2 * hstepB;
    const unsigned ldsw = (unsigned)wid * 1024u;
    const int aoff = lds_byte(wr * 64 + fr, fq * 8), boff = lds_byte(wc * 32 + fr, fq * 8);
#define PG8_SA(b, h) (((b) * 2 + (h)) * HTB)
#define PG8_SB(b, h) ((4 + (b) * 2 + (h)) * HTB)
#define PG8_STAGE(bufoff, gbase, voff) do { _Pragma("unroll") for (int _i = 0; _i < 2; ++_i) \
        __builtin_amdgcn_global_load_lds((const unsigned*)((const char*)(gbase) + (voff)[_i]), (LAS unsigned*)(lds + (bufoff) + ldsw + _i * 8192), 16, 0, 0); } while (0)
#define PG8_LDA(dst, b, h) do { _Pragma("unroll") for (int m = 0; m < 4; ++m) _Pragma("unroll") for (int k = 0; k < 2; ++k) dst[m][k] = *(const LAS bf16x8*)(lds + PG8_SA(b, h) + aoff + m * 2048 + k * 1024); } while (0)
#define PG8_LDB(dst, b, h) do { _Pragma("unroll") for (int n = 0; n < 2; ++n) _Pragma("unroll") for (int k = 0; k < 2; ++k) dst[n][k] = *(const LAS bf16x8*)(lds + PG8_SB(b, h) + boff + n * 2048 + k * 1024); } while (0)
#define PG8_MMA(ai, bj, At, Bt) do { __builtin_amdgcn_s_setprio(1); _Pragma("unroll") for (int m = 0; m < 4; ++m) _Pragma("unroll") for (int n = 0; n < 2; ++n) _Pragma("unroll") for (int k = 0; k < 2; ++k) \
        acc[ai][bj][m][n] = __builtin_amdgcn_mfma_f32_16x16x32_bf16(Bt[n][k], At[m][k], acc[ai][bj][m][n], 0, 0, 0); __builtin_amdgcn_s_setprio(0); } while (0)
#define PG8_WAIT_V(n) asm volatile("s_waitcnt vmcnt(" #n ")" ::: "memory")
#define PG8_WAIT_L(n) asm volatile("s_waitcnt lgkmcnt(" #n ")" ::: "memory")
#define PG8_BAR __builtin_amdgcn_s_barrier()
#define PG8_SCHED __builtin_amdgcn_sched_barrier(0)
    Unit cur, nxt; int ui = 0;
    if (!S.next(0, cur)) return;
    f32x4 acc[2][2][4][2];
#pragma unroll
    for (int a = 0; a < 2; ++a)
#pragma unroll
        for (int b = 0; b < 2; ++b)
#pragma unroll
            for (int m = 0; m < 4; ++m)
#pragma unroll
                for (int n = 0; n < 2; ++n) acc[a][b][m][n] = (f32x4){0.f, 0.f, 0.f, 0.f};
    bf16x8 At[4][2], B0[2][2], B1[2][2];
    const char* cA = (const char*)g.A + (size_t)cur.pm * tstepA; const char* cB = (const char*)g.Bt + (size_t)cur.pn * tstepB;
    PG8_STAGE(PG8_SB(0, 0), cB, voffB); PG8_STAGE(PG8_SB(0, 1), cB + hstepB, voffB); PG8_STAGE(PG8_SA(0, 0), cA, voffA); PG8_STAGE(PG8_SA(0, 1), cA + hstepA, voffA);
    if (wr == 1) PG8_BAR;
    PG8_WAIT_V(2); PG8_BAR;
    PG8_STAGE(PG8_SB(1, 0), cB + kstep, voffB); PG8_STAGE(PG8_SA(1, 0), cA + kstep, voffA); PG8_STAGE(PG8_SB(1, 1), cB + hstepB + kstep, voffB);
    PG8_WAIT_V(6); PG8_BAR;
    for (;;) {
        const bool has_next = S.next(ui + 1, nxt);
        const char* nA = has_next ? (const char*)g.A + (size_t)nxt.pm * tstepA : cA; const char* nB = has_next ? (const char*)g.Bt + (size_t)nxt.pn * tstepB : cB;
        for (int t = 0; t < nt; t += 2) {
            const bool last = (t == nt - 2);
            const char* a1 = cA + (size_t)(t + 1) * kstep;
            const char* a2 = last ? nA : cA + (size_t)(t + 2) * kstep; const char* b2 = last ? nB : cB + (size_t)(t + 2) * kstep;
            const char* a3 = a2 + kstep; const char* b3 = b2 + kstep;
            PG8_LDB(B0, 0, 0); PG8_LDB(B1, 0, 1); PG8_SCHED; PG8_LDA(At, 0, 0); PG8_STAGE(PG8_SA(1, 1), a1 + hstepA, voffA);
            PG8_WAIT_V(8); PG8_WAIT_L(0); PG8_BAR; PG8_MMA(0, 0, At, B0); PG8_MMA(0, 1, At, B1); PG8_BAR; PG8_SCHED;
            PG8_LDA(At, 0, 1); PG8_STAGE(PG8_SB(0, 0), b2, voffB); PG8_STAGE(PG8_SB(0, 1), b2 + hstepB, voffB); PG8_STAGE(PG8_SA(0, 0), a2, voffA);
            PG8_WAIT_V(8); PG8_WAIT_L(0); PG8_BAR; PG8_MMA(1, 0, At, B0); PG8_MMA(1, 1, At, B1); PG8_BAR; PG8_SCHED;
            PG8_LDB(B0, 1, 0); PG8_LDB(B1, 1, 1); PG8_SCHED; PG8_LDA(At, 1, 0); PG8_STAGE(PG8_SA(0, 1), a2 + hstepA, voffA);
            PG8_WAIT_V(8); PG8_WAIT_L(0); PG8_BAR; PG8_MMA(0, 0, At, B0); PG8_MMA(0, 1, At, B1); PG8_BAR; PG8_SCHED;
            PG8_LDA(At, 1, 1); PG8_STAGE(PG8_SB(1, 0), b3, voffB); PG8_STAGE(PG8_SB(1, 1), b3 + hstepB, voffB); PG8_STAGE(PG8_SA(1, 0), a3, voffA);
            PG8_WAIT_V(8); PG8_WAIT_L(0); PG8_BAR; PG8_MMA(1, 0, At, B0); PG8_MMA(1, 1, At, B1); PG8_BAR; PG8_SCHED;
        }
        if (wr == 0) PG8_BAR;
        { const int t2 = get_tid(wv); E(acc, cur, wr, wc, t2 & 15, (t2 >> 4) & 3); }
        if (!has_next) break;
#pragma unroll
        for (int a = 0; a < 2; ++a)
#pragma unroll
            for (int b = 0; b < 2; ++b)
#pragma unroll
                for (int m = 0; m < 4; ++m)
#pragma unroll
                    for (int n = 0; n < 2; ++n) acc[a][b][m][n] = (f32x4){0.f, 0.f, 0.f, 0.f};
        cur = nxt; cA = nA; cB = nB; ++ui;
        if (wr == 1) PG8_BAR;
    }
    PG8_WAIT_V(0);
    PG8_BAR;
#undef PG8_SA
#undef PG8_SB
#undef PG8_STAGE
#undef PG8_LDA
#undef PG8_LDB
#undef PG8_MMA
#undef PG8_WAIT_V
#undef PG8_WAIT_L
#undef PG8_BAR
#undef PG8_SCHED
}
}
using pg8::Unit;
typedef f32x4 Acc[2][2][4][2];

struct EpiIn {
    bf16_t* Z; float* LF; const u64* rs; const float* lb;
    __device__ __forceinline__ void operator()(const Acc& acc, const Unit& u, int wr, int wc, int fr, int fq) const {
        asm volatile("" : "+v"(fr), "+v"(fq));
        const int pn = u.pn;
        const int kind = (pn < 4) ? 0 : (pn < 8) ? 1 : (pn < 12) ? 2 : (pn < 16) ? 0 : (pn < 19) ? 2 : 3;
        float rstdv[2][4];
#pragma unroll
        for (int ai = 0; ai < 2; ++ai)
#pragma unroll
            for (int m = 0; m < 4; ++m) { const int r = u.pm * 256 + ai * 128 + wr * 64 + m * 16 + fr; rstdv[ai][m] = rs_rstd(rs, r); }
        f32x4 lbv[2][2];
#pragma unroll
        for (int bj = 0; bj < 2; ++bj) { lbv[bj][0] = (f32x4){0.f, 0.f, 0.f, 0.f}; lbv[bj][1] = lbv[bj][0]; }
        if (kind == 1) {
#pragma unroll
            for (int bj = 0; bj < 2; ++bj) { const int cf = pn * 256 + bj * 128 + wc * 32 + 8 * fq - ZF; lbv[bj][0] = *(const f32x4*)(lb + cf); lbv[bj][1] = *(const f32x4*)(lb + cf + 4); }
        }
#pragma unroll
        for (int ai = 0; ai < 2; ++ai)
#pragma unroll
            for (int m = 0; m < 4; ++m) {
                const int r = u.pm * 256 + ai * 128 + wr * 64 + m * 16 + fr;
                const float rstd = rstdv[ai][m];
#pragma unroll
                for (int bj = 0; bj < 2; ++bj) {
                    const int c = pn * 256 + bj * 128 + wc * 32 + 8 * fq;
                    f32x4 v0 = acc[ai][bj][m][0] * rstd, v1 = acc[ai][bj][m][1] * rstd;
                    if (kind == 1) {
                        const int cf = c - ZF;
                        const f32x4 l0 = lbv[bj][0], l1 = lbv[bj][1];
                        f32x4 o0, o1;
#pragma unroll
                        for (int j = 0; j < 4; ++j) { o0[j] = __logf(l0[j] + (1.0f - l0[j]) * fsigmoid(v0[j])); o1[j] = __logf(l1[j] + (1.0f - l1[j]) * fsigmoid(v1[j])); }
                        float* d = LF + (size_t)r * 1024 + cf; *(f32x4*)d = o0; *(f32x4*)(d + 4) = o1;
                    } else {
                        if (kind == 0) {
#pragma unroll
                            for (int j = 0; j < 4; ++j) { v0[j] = fsilu(v0[j]); v1[j] = fsilu(v1[j]); }
                        } else if (kind == 3) {
#pragma unroll
                            for (int j = 0; j < 4; ++j) { v0[j] = fgelu(v0[j]); v1[j] = fgelu(v1[j]); }
                        }
                        u32x4 w; w.x = pk2(v0[0], v0[1]); w.y = pk2(v0[2], v0[3]); w.z = pk2(v1[0], v1[1]); w.w = pk2(v1[2], v1[3]);
                        *(u32x4*)(Z + (size_t)r * DIN + c) = w;
                    }
                }
            }
    }
};
struct EpiRes {
    const bf16_t* RB; bf16_t* XB; u64* rs_out;
    __device__ __forceinline__ void operator()(const Acc& acc, const Unit& u, int wr, int wc, int fr, int fq) const {
        asm volatile("" : "+v"(fr), "+v"(fq));
        u32x4 rv[2][4][2];
#pragma unroll
        for (int ai = 0; ai < 2; ++ai)
#pragma unroll
            for (int m = 0; m < 4; ++m)
#pragma unroll
                for (int bj = 0; bj < 2; ++bj) rv[ai][m][bj] = *(const u32x4*)(RB + (size_t)(u.pm * 256 + ai * 128 + wr * 64 + m * 16 + fr) * DM + u.pn * 256 + bj * 128 + wc * 32 + 8 * fq);
#pragma unroll
        for (int ai = 0; ai < 2; ++ai)
#pragma unroll
            for (int m = 0; m < 4; ++m) {
                const int r = u.pm * 256 + ai * 128 + wr * 64 + m * 16 + fr;
                float ss = 0.f;
#pragma unroll
                for (int bj = 0; bj < 2; ++bj) {
                    const int c = u.pn * 256 + bj * 128 + wc * 32 + 8 * fq;
                    const u32x4 w0 = rv[ai][m][bj];
                    const f32x4 y0 = (f32x4){lo16(w0.x), hi16(w0.x), lo16(w0.y), hi16(w0.y)} + acc[ai][bj][m][0], y1 = (f32x4){lo16(w0.z), hi16(w0.z), lo16(w0.w), hi16(w0.w)} + acc[ai][bj][m][1];
                    u32x4 w; w.x = pk2(y0[0], y0[1]); w.y = pk2(y0[2], y0[3]); w.z = pk2(y1[0], y1[1]); w.w = pk2(y1[2], y1[3]);
                    *(u32x4*)(XB + (size_t)r * DM + c) = w;
                    ss += (y0[0] * y0[0] + y0[1] * y0[1]) + (y0[2] * y0[2] + y0[3] * y0[3]) + (y1[0] * y1[0] + y1[1] * y1[1]) + (y1[2] * y1[2] + y1[3] * y1[3]);
                }
                ss += __shfl_xor(ss, 16); ss += __shfl_xor(ss, 32);
                if (fq == 0) atomicAdd(rs_out + r, (u64)(ss * RS_SCALE));
            }
    }
};
struct EpiUp {
    bf16_t* ACT; bf16_t* SIDE; const u64* rs; const float* cw; const float* cb; float* conv_p; float* conv_s;
    __device__ __forceinline__ void operator()(const Acc& acc, const Unit& u, int wr, int wc, int fr, int fq) const {
        asm volatile("" : "+v"(fr), "+v"(fq));
        const int pn = u.pn;
        {
            float rstdv[2][4];
#pragma unroll
            for (int ai = 0; ai < 2; ++ai)
#pragma unroll
                for (int m = 0; m < 4; ++m) rstdv[ai][m] = rs_rstd(rs, u.pm * 256 + ai * 128 + wr * 64 + m * 16 + fr);
#pragma unroll
            for (int n = 0; n < 2; ++n) {
                __builtin_amdgcn_sched_barrier(0);
                const int ca = pn * 128 + wc * 32 + 8 * fq + 4 * n;
                f32x4 wgn[3], wvn[3];
#pragma unroll
                for (int k = 0; k < 3; ++k) { wgn[k] = *(const f32x4*)(cw + k * DFF2 + ca); wvn[k] = *(const f32x4*)(cw + k * DFF2 + DFF + ca); }
                const f32x4 bgn = *(const f32x4*)(cb + ca), bvn = *(const f32x4*)(cb + DFF + ca);
#pragma unroll
                for (int ai = 0; ai < 2; ++ai) {
                    f32x4 pg = (f32x4){0.f, 0.f, 0.f, 0.f}, pv = pg;
#pragma unroll
                    for (int m = 0; m < 4; ++m) {
                        const int r = u.pm * 256 + ai * 128 + wr * 64 + m * 16 + fr;
                        const float rstd = rstdv[ai][m];
                        const f32x4 xg = acc[ai][0][m][n] * rstd, xv = acc[ai][1][m][n] * rstd;
                        f32x4 o;
#pragma unroll
                        for (int j = 0; j < 4; ++j) {
                            const float g1 = dpp_shr1(dpp_ror1(pg[j]), xg[j]), g2 = dpp_shr2(dpp_ror2(pg[j]), xg[j]);
                            const float v1 = dpp_shr1(dpp_ror1(pv[j]), xv[j]), v2 = dpp_shr2(dpp_ror2(pv[j]), xv[j]);
                            const float cg_ = bgn[j] + wgn[0][j] * g2 + wgn[1][j] * g1 + wgn[2][j] * xg[j];
                            const float cv_ = bvn[j] + wvn[0][j] * v2 + wvn[1][j] * v1 + wvn[2][j] * xv[j];
                            o[j] = fsilu(cg_) * cv_;
                        }
                        if (!(m == 0 && fr < 2)) { u32x2 w; w.x = pk2(o[0], o[1]); w.y = pk2(o[2], o[3]); *(u32x2*)(ACT + (size_t)r * DFF + ca) = w; }
                        if ((m == 0 && fr < 2) || (m == 3 && fr >= 14)) {
                            const int slot = (m == 0) ? 2 + fr : fr - 14;
                            bf16_t* sd = SIDE + ((size_t)(r >> 6) * 4 + slot) * DFF2 + ca;
                            u32x2 w2; w2.x = pk2(xg[0], xg[1]); w2.y = pk2(xg[2], xg[3]); *(u32x2*)sd = w2;
                            w2.x = pk2(xv[0], xv[1]); w2.y = pk2(xv[2], xv[3]); *(u32x2*)(sd + DFF) = w2;
                        }
                        if (m == 3 && fr >= 14 && (r & 2047) >= 2046) {
                            float* d = conv_p + ((size_t)(r >> 11) * 2 + ((r & 2047) - 2046)) * DFF2 + ca;
                            *(f32x4*)d = xg; *(f32x4*)(d + DFF) = xv;
                        }
                        pg = xg; pv = xv;
                    }
                }
            }
        }
    }
};
struct EpiProj {
    bf16_t* O;
    __device__ __forceinline__ void operator()(const Acc& acc, const Unit& u, int wr, int wc, int fr, int fq) const {
        asm volatile("" : "+v"(fr), "+v"(fq));
#pragma unroll
        for (int ai = 0; ai < 2; ++ai)
#pragma unroll
            for (int m = 0; m < 4; ++m) {
                const int r = u.pm * 256 + ai * 128 + wr * 64 + m * 16 + fr;
#pragma unroll
                for (int bj = 0; bj < 2; ++bj) {
                    const int c = u.pn * 256 + bj * 128 + wc * 32 + 8 * fq;
                    const f32x4 v0 = acc[ai][bj][m][0], v1 = acc[ai][bj][m][1];
                    u32x4 w; w.x = pk2(v0[0], v0[1]); w.y = pk2(v0[2], v0[3]); w.z = pk2(v1[0], v1[1]); w.w = pk2(v1[2], v1[3]);
                    *(u32x4*)(O + (size_t)r * DM + c) = w;
                }
            }
    }
};
struct EpiGate {
    const bf16_t* RB; const bf16_t* PP; bf16_t* XBo; float* Xout; const u64* rs; u64* rs_out;
    __device__ __forceinline__ void operator()(const Acc& acc, const Unit& u, int wr, int wc, int fr, int fq) const {
        asm volatile("" : "+v"(fr), "+v"(fq));
        float rstdv[2][4];
#pragma unroll
        for (int ai = 0; ai < 2; ++ai)
#pragma unroll
            for (int m = 0; m < 4; ++m) rstdv[ai][m] = rs_rstd(rs, u.pm * 256 + ai * 128 + wr * 64 + m * 16 + fr);
#pragma unroll
        for (int ai = 0; ai < 2; ++ai) {
            u32x4 pw[4][2], xw[4][2];
#pragma unroll
            for (int m = 0; m < 4; ++m)
#pragma unroll
                for (int bj = 0; bj < 2; ++bj) { const size_t o = (size_t)(u.pm * 256 + ai * 128 + wr * 64 + m * 16 + fr) * DM + u.pn * 256 + bj * 128 + wc * 32 + 8 * fq;
                    pw[m][bj] = *(const u32x4*)(PP + o); xw[m][bj] = *(const u32x4*)(RB + o); }
#pragma unroll
            for (int m = 0; m < 4; ++m) {
                const int r = u.pm * 256 + ai * 128 + wr * 64 + m * 16 + fr;
                float ss = 0.f;
#pragma unroll
                for (int bj = 0; bj < 2; ++bj) {
                    const int c = u.pn * 256 + bj * 128 + wc * 32 + 8 * fq;
                    const f32x4 a0 = acc[ai][bj][m][0] * rstdv[ai][m], a1 = acc[ai][bj][m][1] * rstdv[ai][m];
                    const u32x4 pq = pw[m][bj], xq = xw[m][bj];
                    f32x4 y0, y1;
                    y0[0] = lo16(xq.x) + fsigmoid(a0[0]) * lo16(pq.x); y0[1] = hi16(xq.x) + fsigmoid(a0[1]) * hi16(pq.x);
                    y0[2] = lo16(xq.y) + fsigmoid(a0[2]) * lo16(pq.y); y0[3] = hi16(xq.y) + fsigmoid(a0[3]) * hi16(pq.y);
                    y1[0] = lo16(xq.z) + fsigmoid(a1[0]) * lo16(pq.z); y1[1] = hi16(xq.z) + fsigmoid(a1[1]) * hi16(pq.z);
                    y1[2] = lo16(xq.w) + fsigmoid(a1[2]) * lo16(pq.w); y1[3] = hi16(xq.w) + fsigmoid(a1[3]) * hi16(pq.w);
                    if (Xout) { float* d = Xout + (size_t)r * DM + c; *(f32x4*)d = y0; *(f32x4*)(d + 4) = y1; }
                    else { u32x4 w; w.x = pk2(y0[0], y0[1]); w.y = pk2(y0[2], y0[3]); w.z = pk2(y1[0], y1[1]); w.w = pk2(y1[2], y1[3]);
                        *(u32x4*)(XBo + (size_t)r * DM + c) = w; }
                    ss += (y0[0] * y0[0] + y0[1] * y0[1]) + (y0[2] * y0[2] + y0[3] * y0[3]) + (y1[0] * y1[0] + y1[1] * y1[1]) + (y1[2] * y1[2] + y1[3] * y1[3]);
                }
                ss += __shfl_xor(ss, 16); ss += __shfl_xor(ss, 32);
                if (fq == 0 && !Xout) atomicAdd(rs_out + r, (u64)(ss * RS_SCALE));
            }
        }
    }
};

template <int NT, class Epi>
__device__ __forceinline__ void skinny_phase(int wv, LAS unsigned char* lds, const bf16_t* A, int lda, const bf16_t* Bt, int K, int nstrips, const Epi& E, int nslack = 0) {
    const int tid = get_tid(wv) & 511; const int lane = tid & 63, wave = __builtin_amdgcn_readfirstlane(tid >> 6) & 7, i16 = lane & 15, q4 = lane >> 4;
    const int G = gridDim.x;
    LAS bf16_t* AL = (LAS bf16_t*)lds;
    LAS bf16_t* BL = (LAS bf16_t*)(lds + 128 * 264 * 2);
    const int prow = tid >> 5, pk = (tid & 31) * 8;
    const int sstep = nslack > 0 ? nslack : G;
    if (nslack > 0 && (int)blockIdx.x < G - nslack) return;
    for (int s = G - 1 - (int)blockIdx.x; s < nstrips; s += sstep) {
        const int n0 = s * 16 * NT;
        f32x4 acc[NT];
#pragma unroll
        for (int nt = 0; nt < NT; ++nt) acc[nt] = (f32x4){0.f, 0.f, 0.f, 0.f};
        const bf16_t* ap = A + (size_t)prow * lda + pk;
        const bf16_t* bp = Bt + (size_t)(n0 + prow) * K + pk;
        u32x4 ra[8], rb[NT];
#pragma unroll
        for (int i = 0; i < 8; ++i) ra[i] = *(const u32x4*)(ap + (size_t)(16 * i) * lda);
#pragma unroll
        for (int nt = 0; nt < NT; ++nt) rb[nt] = *(const u32x4*)(bp + (size_t)(16 * nt) * K);
#pragma unroll 1
        for (int k0 = 0; k0 < K; k0 += 256) {
            __syncthreads();
#pragma unroll
            for (int i = 0; i < 8; ++i) *(LAS u32x4*)(AL + (prow + 16 * i) * 264 + pk) = ra[i];
#pragma unroll
            for (int nt = 0; nt < NT; ++nt) *(LAS u32x4*)(BL + (prow + 16 * nt) * 264 + pk) = rb[nt];
            __syncthreads();
            if (k0 + 256 < K) {
#pragma unroll
                for (int i = 0; i < 8; ++i) ra[i] = *(const u32x4*)(ap + (size_t)(16 * i) * lda + k0 + 256);
#pragma unroll
                for (int nt = 0; nt < NT; ++nt) rb[nt] = *(const u32x4*)(bp + (size_t)(16 * nt) * K + k0 + 256);
            }
#pragma unroll
            for (int u = 0; u < 8; ++u) { const bf16x8 a = frag((const LAS unsigned char*)AL, 264, 16 * wave + i16, 32 * u + 8 * q4);
#pragma unroll
                for (int nt = 0; nt < NT; ++nt) acc[nt] = MFMA16(a, frag((const LAS unsigned char*)BL, 264, 16 * nt + i16, 32 * u + 8 * q4), acc[nt]); }
        }
        { int i16v = i16, q4v = q4; asm volatile("" : "+v"(i16v), "+v"(q4v));
#pragma unroll
          for (int nt = 0; nt < NT; ++nt) E(acc[nt], wave, i16v, q4v, n0 + 16 * nt); }
    }
    __syncthreads();
}
struct SkIn {
    bf16_t* Z; float* LF; const u64* rs; const float* lb;
    __device__ __forceinline__ void operator()(const f32x4& acc, int wave, int i16, int q4, int nb) const {
        const int kind = (nb < 1024) ? 0 : (nb < 2048) ? 1 : (nb < 3072) ? 2 : (nb < 4096) ? 0 : (nb < 4864) ? 2 : 3;
        const int n = nb + i16;
#pragma unroll
        for (int jj = 0; jj < 4; ++jj) { const int r = MPR + 16 * wave + 4 * q4 + jj; const float v = acc[jj] * rs_rstd(rs, r);
            if (kind == 1) { const float lbv = lb[n - ZF]; LF[(size_t)r * 1024 + n - ZF] = __logf(lbv + (1.0f - lbv) * fsigmoid(v)); }
            else Z[(size_t)r * DIN + n] = (bf16_t)f2bf(kind == 0 ? fsilu(v) : kind == 3 ? fgelu(v) : v); }
    }
};
struct SkRes {
    const bf16_t* RB; bf16_t* XB; u64* rs_out;
    __device__ __forceinline__ void operator()(const f32x4& acc, int wave, int i16, int q4, int nb) const {
        const int n = nb + i16;
#pragma unroll
        for (int jj = 0; jj < 4; ++jj) { const int r = MPR + 16 * wave + 4 * q4 + jj; const float y = bf2f(RB[(size_t)r * DM + n]) + acc[jj];
            XB[(size_t)r * DM + n] = (bf16_t)f2bf(y);
            float ss = y * y; ss += __shfl_xor(ss, 1); ss += __shfl_xor(ss, 2); ss += __shfl_xor(ss, 4); ss += __shfl_xor(ss, 8);
            if (i16 == 0) atomicAdd(rs_out + r, (u64)(ss * RS_SCALE)); }
    }
};
struct SkUp {
    const u64* rs; float* conv_s;
    __device__ __forceinline__ void operator()(const f32x4& acc, int wave, int i16, int q4, int nb) const {
        const int n = nb + i16, orig = ((n >> 7) & 1) * DFF + (n >> 8) * 128 + (n & 127);
#pragma unroll
        for (int jj = 0; jj < 4; ++jj) { const int sidx = 16 * wave + 4 * q4 + jj; conv_s[(size_t)sidx * 2 * DFF2 + DFF2 + orig] = acc[jj] * rs_rstd(rs, MPR + sidx); }
    }
};
struct SkProj {
    bf16_t* O;
    __device__ __forceinline__ void operator()(const f32x4& acc, int wave, int i16, int q4, int nb) const {
#pragma unroll
        for (int jj = 0; jj < 4; ++jj) O[(size_t)(MPR + 16 * wave + 4 * q4 + jj) * DM + nb + i16] = (bf16_t)f2bf(acc[jj]);
    }
};
struct SkGate {
    const bf16_t* RB; const bf16_t* PP; bf16_t* XBo; float* Xout; const u64* rs; u64* rs_out;
    __device__ __forceinline__ void operator()(const f32x4& acc, int wave, int i16, int q4, int nb) const {
        const int n = nb + i16;
#pragma unroll
        for (int jj = 0; jj < 4; ++jj) { const int r = MPR + 16 * wave + 4 * q4 + jj;
            const float y = bf2f(RB[(size_t)r * DM + n]) + fsigmoid(acc[jj] * rs_rstd(rs, r)) * bf2f(PP[(size_t)r * DM + n]);
            if (Xout) Xout[(size_t)r * DM + n] = y;
            XBo[(size_t)r * DM + n] = (bf16_t)f2bf(y);
            float ss = y * y; ss += __shfl_xor(ss, 1); ss += __shfl_xor(ss, 2); ss += __shfl_xor(ss, 4); ss += __shfl_xor(ss, 8);
            if (i16 == 0) atomicAdd(rs_out + r, (u64)(ss * RS_SCALE)); }
    }
};

struct TrDesc { const float* W; bf16_t* WT; const float* gain; int K, N, k0, n0, s0; };
__device__ __forceinline__ TrDesc tr_decode(const Params& p, int it) {
    constexpr int I_IN = 32 * (DIN / 32), I_OUT = 32 * 64, I_UP = 32 * (DFF2 / 32), I_DOWN = (DFF / 64) * 64, I_GATE = 32 * 64, I_PROJ = 4 * 64;
    constexpr int I_LAYER = I_IN + I_OUT + I_UP + I_DOWN + I_GATE + I_PROJ;
    const int l = it / I_LAYER; int r = it % I_LAYER;
    bf16_t* wl = (bf16_t*)(p.ws + WS_WT) + (size_t)l * WT_LAYER;
    TrDesc d; bool up = false;
    if (r < I_IN) { d.W = p.in[9] + (size_t)l * DM * DIN; d.K = DM; d.N = DIN; d.WT = wl + WT_IN; d.gain = p.in[8] + l * DM; }
    else if ((r -= I_IN) < I_OUT) { d.W = p.in[19] + (size_t)l * DM * DM; d.K = DM; d.N = DM; d.WT = wl + WT_OUT; d.gain = nullptr; }
    else if ((r -= I_OUT) < I_UP) { d.W = p.in[21] + (size_t)l * DM * DFF2; d.K = DM; d.N = DFF2; d.WT = wl + WT_UP; d.gain = p.in[20] + l * DM; up = true; }
    else if ((r -= I_UP) < I_DOWN) { d.W = p.in[24] + (size_t)l * DFF * DM; d.K = DFF; d.N = DM; d.WT = wl + WT_DOWN; d.gain = nullptr; }
    else if ((r -= I_DOWN) < I_GATE) { d.W = p.in[26] + (size_t)l * DM * DM; d.K = DM; d.N = DM; d.WT = wl + WT_GATE; d.gain = p.in[25] + l * DM; }
    else { r -= I_GATE; d.W = p.in[27] + (size_t)l * PLE * DM; d.K = PLE; d.N = DM; d.WT = wl + WT_PROJ; d.gain = nullptr; }
    const int nblk = d.N / 32, kb = r / nblk, nb = r % nblk; d.k0 = 64 * kb; d.n0 = 32 * nb;
    d.s0 = up ? ((d.n0 >> 7) & 1) * DFF + (d.n0 >> 8) * 128 + (d.n0 & 127) : d.n0;
    return d;
}
__device__ __forceinline__ void tr_load(const TrDesc& d, int lane, float (&tv)[32]) {
#pragma unroll
    for (int i = 0; i < 32; ++i) { const int kk = 2 * i + (lane >> 5); tv[i] = d.W[(size_t)(d.k0 + kk) * d.N + d.s0 + (lane & 31)]; }
}
__device__ __forceinline__ void tr_store(const TrDesc& d, LAS float* scr, int lane, float (&tv)[32]) {
    if (d.gain) {
#pragma unroll
        for (int i = 0; i < 32; ++i) tv[i] *= d.gain[d.k0 + 2 * i + (lane >> 5)];
    }
#pragma unroll
    for (int i = 0; i < 32; ++i) scr[(2 * i + (lane >> 5)) * 33 + (lane & 31)] = tv[i];
    asm volatile("s_waitcnt lgkmcnt(0)" ::: "memory");
    const int c = lane & 7;
#pragma unroll
    for (int j = 0; j < 4; ++j) { const int n = (lane >> 3) + 8 * j; const LAS float* s = scr + (8 * c) * 33 + n;
        u32x4 o; o.x = pk2(s[0 * 33], s[1 * 33]); o.y = pk2(s[2 * 33], s[3 * 33]); o.z = pk2(s[4 * 33], s[5 * 33]); o.w = pk2(s[6 * 33], s[7 * 33]);
        *(u32x4*)(d.WT + (size_t)(d.n0 + n) * d.K + d.k0 + 8 * c) = o; }
    asm volatile("s_waitcnt lgkmcnt(0)" ::: "memory");
}
__device__ __forceinline__ void phase_prep(int wv, const Params& p, LAS unsigned char* lds) {
    const int tid = get_tid(wv); const int lane = tid & 63, wave = __builtin_amdgcn_readfirstlane(tid >> 6);
    const int G = gridDim.x, gw = blockIdx.x * 8 + wave, NGW = G * 8;
    const int gt = blockIdx.x * 512 + tid, NGT = G * 512;
    u64* RS = (u64*)(p.ws + WS_RS);
    for (int i = gt; i < 6 * MP; i += NGT) RS[MP + i] = 0ull;
    float* LBS = (float*)(p.ws + WS_LBS);
    for (int i = gt; i < 1024; i += NGT) { LBS[i] = 0.f; LBS[1024 + i] = 1.0f / (1.0f + __expf(p.in[10][i] - p.in[10][1024 + i])); }
    LAS float* scr = (LAS float*)(lds + wave * 16384);
    constexpr int I_TOTAL = 2 * (32 * (DIN / 32) + 32 * 64 + 32 * (DFF2 / 32) + (DFF / 64) * 64 + 32 * 64 + 4 * 64);
    {
        float tva[32], tvb[32];
        int it = gw;
        TrDesc da = tr_decode(p, it < I_TOTAL ? it : 0), db = da;
        if (it < I_TOTAL) tr_load(da, lane, tva);
        while (it < I_TOTAL) {
            const int nx = it + NGW;
            if (nx < I_TOTAL) { db = tr_decode(p, nx); tr_load(db, lane, tvb); }
            tr_store(da, scr, lane, tva);
            it = nx;
            if (it >= I_TOTAL) break;
            const int nx2 = it + NGW;
            if (nx2 < I_TOTAL) { da = tr_decode(p, nx2); tr_load(da, lane, tva); }
            tr_store(db, scr, lane, tvb);
            it = nx2;
        }
    }
    bf16_t* XB0 = (bf16_t*)(p.ws + WS_XB0);
    for (int r0 = gw; r0 < MV; r0 += 2 * NGW) {
        const int r1 = r0 + NGW; const bool has1 = r1 < MV; const int r1c = has1 ? r1 : r0;
        const float* s0 = (r0 < MPR) ? p.in[0] + (size_t)r0 * DM : p.in[1] + (size_t)(r0 - MPR) * DM;
        const float* s1 = (r1c < MPR) ? p.in[0] + (size_t)r1c * DM : p.in[1] + (size_t)(r1c - MPR) * DM;
        f32x4 va[8], vb[8];
#pragma unroll
        for (int j = 0; j < 8; ++j) { va[j] = *(const f32x4*)(s0 + j * 256 + lane * 4); vb[j] = *(const f32x4*)(s1 + j * 256 + lane * 4); }
        float ssa = 0.f, ssb = 0.f;
#pragma unroll
        for (int j = 0; j < 8; ++j) { ssa += (va[j][0] * va[j][0] + va[j][1] * va[j][1]) + (va[j][2] * va[j][2] + va[j][3] * va[j][3]);
            ssb += (vb[j][0] * vb[j][0] + vb[j][1] * vb[j][1]) + (vb[j][2] * vb[j][2] + vb[j][3] * vb[j][3]); }
#pragma unroll
        for (int j = 0; j < 8; ++j) { u32x2 w; w.x = pk2(va[j][0], va[j][1]); w.y = pk2(va[j][2], va[j][3]); *(u32x2*)(XB0 + (size_t)r0 * DM + j * 256 + lane * 4) = w;
            if (has1) { w.x = pk2(vb[j][0], vb[j][1]); w.y = pk2(vb[j][2], vb[j][3]); *(u32x2*)(XB0 + (size_t)r1 * DM + j * 256 + lane * 4) = w; } }
        ssa = wave_sum(ssa); ssb = wave_sum(ssb);
        if (lane == 0) { RS[r0] = (u64)(ssa * RS_SCALE); if (has1) RS[r1] = (u64)(ssb * RS_SCALE); }
    }
    bf16_t* PB = (bf16_t*)(p.ws + WS_PB);
    for (int i0 = gw; i0 < 2 * MV; i0 += 4 * NGW) {
        f32x4 v[4]; size_t dst[4]; bool ok[4];
#pragma unroll
        for (int u = 0; u < 4; ++u) { const int i = i0 + u * NGW; ok[u] = i < 2 * MV; const int ic = ok[u] ? i : i0; const int l = ic / MV, r = ic % MV;
            const float* src = (r < MPR) ? p.in[6] + ((size_t)l * MPR + r) * PLE : p.in[7] + ((size_t)l * NSAMP + (r - MPR)) * PLE;
            v[u] = *(const f32x4*)(src + lane * 4); dst[u] = ((size_t)l * MP + r) * PLE + lane * 4; }
#pragma unroll
        for (int u = 0; u < 4; ++u) if (ok[u]) { u32x2 w; w.x = pk2(v[u][0], v[u][1]); w.y = pk2(v[u][2], v[u][3]); *(u32x2*)(PB + dst[u]) = w; }
    }
}

constexpr int H_WTOT = 0;
constexpr int H_QT = 4096;
constexpr int H_QH = H_QT + 8704;
constexpr int H_KT = H_QH + 8704;
constexpr int H_KTT = H_KT + 8704;
constexpr int H_VT = H_KTT + 10240;
constexpr int H_ST = H_VT + 10240;
constexpr int H_PS = H_ST + 34816;
constexpr int H_GD = H_PS + 2560;
constexpr int H_OSS = H_GD + 512;
constexpr int H_OT = H_OSS + 1024;
static_assert(H_OT + 8704 <= LDS_BYTES - 16, "hgrn lds");
__device__ __forceinline__ void hgrn_pass1_item(int wv, const Params& p, unsigned char* hsc, int l, int item, LAS unsigned char* lds) {
    const int c = item & 15, h = (item >> 4) & 7, b = item >> 7;
    const int tid = get_tid(wv); const int lane = tid & 63, wave = __builtin_amdgcn_readfirstlane(tid >> 6);
    bf16_t* Z = (bf16_t*)(p.ws + WS_Z); const float* LF = (const float*)(p.ws + WS_LF); bf16_t* MIX = (bf16_t*)(p.ws + WS_MIX);
    LAS float* WTOT = (LAS float*)(lds + H_WTOT); LAS float* GD = (LAS float*)(lds + H_GD); LAS float* OSS = (LAS float*)(lds + H_OSS);
    LAS bf16_t* QT = (LAS bf16_t*)(lds + H_QT); LAS bf16_t* QH = (LAS bf16_t*)(lds + H_QH); LAS bf16_t* KT = (LAS bf16_t*)(lds + H_KT);
    LAS bf16_t* KTT = (LAS bf16_t*)(lds + H_KTT); LAS bf16_t* VT = (LAS bf16_t*)(lds + H_VT); LAS bf16_t* ST = (LAS bf16_t*)(lds + H_ST); LAS bf16_t* PS = (LAS bf16_t*)(lds + H_PS);
    LAS bf16_t* OT = (LAS bf16_t*)(lds + H_OT);
    __syncthreads();
    for (int i = tid; i < 128 * 136 / 2; i += 512) ((LAS unsigned*)ST)[i] = 0u;
    f32x4 Sacc[8];
#pragma unroll
    for (int k = 0; k < 8; ++k) Sacc[k] = (f32x4){0.f, 0.f, 0.f, 0.f};
    const size_t row0 = (size_t)b * SEQ + (size_t)c * 128;
    float bsum[8] = {0.f, 0.f, 0.f, 0.f, 0.f, 0.f, 0.f, 0.f};
    u32x4 q8r, v8r; f32x4 lfa, lfb;
    { const int tt = tid >> 4, k8 = (tid & 15) * 8; const size_t r = row0 + tt; q8r = *(const u32x4*)(Z + r * DIN + ZQ + h * 128 + k8); v8r = *(const u32x4*)(Z + r * DIN + ZI + h * 128 + k8);
      lfa = *(const f32x4*)(LF + r * 1024 + h * 128 + k8); lfb = *(const f32x4*)(LF + r * 1024 + h * 128 + k8 + 4); }
    const int tt0 = tid >> 4, k80 = (tid & 15) * 8, i160 = lane & 15, q40 = lane >> 4;
    for (int j = 0; j < 4; ++j) {
        int tt = tt0, k8 = k80, i16 = i160, q4 = q40;
        asm volatile("" : "+v"(tt), "+v"(k8), "+v"(i16), "+v"(q4));
        const int vcol = h * 128 + 16 * wave + i16;
        float lf[8] = {lfa[0], lfa[1], lfa[2], lfa[3], lfb[0], lfb[1], lfb[2], lfb[3]};
        float pb[8];
#pragma unroll
        for (int i = 0; i < 8; ++i) { float x = lf[i]; float y = __shfl_up(x, 16); if (q4 >= 1) x += y; y = __shfl_up(x, 32); if (q4 >= 2) x += y; pb[i] = x; }
        if (q4 == 3) { *(LAS f32x4*)(WTOT + wave * 128 + k8) = (f32x4){pb[0], pb[1], pb[2], pb[3]}; *(LAS f32x4*)(WTOT + wave * 128 + k8 + 4) = (f32x4){pb[4], pb[5], pb[6], pb[7]}; }
        __syncthreads();
        if (j > 0) *(u32x4*)(MIX + (row0 + (size_t)(j - 1) * 32 + tt) * DM + h * 128 + k8) = *(const LAS u32x4*)(OT + tt * 136 + k8);
        float off[8], tot[8];
#pragma unroll
        for (int i = 0; i < 8; ++i) { off[i] = 0.f; tot[i] = 0.f; }
#pragma unroll
        for (int w2 = 0; w2 < 8; ++w2) { const f32x4 a = *(const LAS f32x4*)(WTOT + w2 * 128 + k8), c = *(const LAS f32x4*)(WTOT + w2 * 128 + k8 + 4);
            const float m = (w2 < wave) ? 1.f : 0.f;
#pragma unroll
            for (int i = 0; i < 4; ++i) { tot[i] += a[i]; tot[4 + i] += c[i]; off[i] += m * a[i]; off[4 + i] += m * c[i]; } }
        const unsigned qw[4] = {q8r.x, q8r.y, q8r.z, q8r.w}, vw[4] = {v8r.x, v8r.y, v8r.z, v8r.w};
        float qt[8], qh[8], kt[8];
#pragma unroll
        for (int i = 0; i < 8; ++i) {
            const float bc = pb[i] + off[i], bl = tot[i];
            const float q = (i & 1) ? hi16(qw[i >> 1]) : lo16(qw[i >> 1]);
            const float kk = 1.0f - __expf(lf[i]);
            qt[i] = q * __expf(bc); qh[i] = q * __expf(fminf(bc - bl, 80.f)); kt[i] = kk * __expf(bl - bc);
        }
        { float e[8];
#pragma unroll
          for (int i = 0; i < 8; ++i) { e[i] = qt[i] * __expf(bsum[i]); bsum[i] += tot[i]; }
          u32x4 w; w.x = pk2(e[0], e[1]); w.y = pk2(e[2], e[3]); w.z = pk2(e[4], e[5]); w.w = pk2(e[6], e[7]);
          *(u32x4*)(Z + (row0 + (size_t)j * 32 + tt) * DIN + ZQ + h * 128 + k8) = w; }
        { u32x4 w; w.x = pk2(qt[0], qt[1]); w.y = pk2(qt[2], qt[3]); w.z = pk2(qt[4], qt[5]); w.w = pk2(qt[6], qt[7]); *(LAS u32x4*)(QT + tt * 136 + k8) = w;
          w.x = pk2(qh[0], qh[1]); w.y = pk2(qh[2], qh[3]); w.z = pk2(qh[4], qh[5]); w.w = pk2(qh[6], qh[7]); *(LAS u32x4*)(QH + tt * 136 + k8) = w;
          w.x = pk2(kt[0], kt[1]); w.y = pk2(kt[2], kt[3]); w.z = pk2(kt[4], kt[5]); w.w = pk2(kt[6], kt[7]); *(LAS u32x4*)(KT + tt * 136 + k8) = w; }
#pragma unroll
        for (int i = 0; i < 8; ++i) { const int rw = swz8(k8 + i); KTT[rw * 40 + tt] = (bf16_t)f2bf(kt[i]); VT[rw * 40 + tt] = (bf16_t)((i & 1) ? (vw[i >> 1] >> 16) : (vw[i >> 1] & 0xffffu)); }
        if (tid < 16) {
#pragma unroll
            for (int i = 0; i < 8; ++i) GD[k8 + i] = __expf(tot[i]);
        }
        __syncthreads();
        if (j + 1 < 4) { const size_t r = row0 + (size_t)(j + 1) * 32 + tt; q8r = *(const u32x4*)(Z + r * DIN + ZQ + h * 128 + k8); v8r = *(const u32x4*)(Z + r * DIN + ZI + h * 128 + k8);
            lfa = *(const f32x4*)(LF + r * 1024 + h * 128 + k8); lfb = *(const f32x4*)(LF + r * 1024 + h * 128 + k8 + 4); }
        if (wave < 3) {
            const int t2 = (wave == 0) ? 0 : 1, s2 = (wave == 2) ? 1 : 0;
            f32x4 a = (f32x4){0.f, 0.f, 0.f, 0.f};
#pragma unroll
            for (int ks = 0; ks < 4; ++ks) a = MFMA16(frag((const LAS unsigned char*)KT, 136, 16 * s2 + i16, 32 * ks + 8 * q4), frag((const LAS unsigned char*)QH, 136, 16 * t2 + i16, 32 * ks + 8 * q4), a);
            const int t = 16 * t2 + i16, s = 16 * s2 + 4 * q4;
            u32x2 w; w.x = pk2(s <= t ? a[0] : 0.f, s + 1 <= t ? a[1] : 0.f); w.y = pk2(s + 2 <= t ? a[2] : 0.f, s + 3 <= t ? a[3] : 0.f);
            *(LAS u32x2*)(PS + t * 40 + s) = w;
        } else if (wave == 3) { u32x2 w; w.x = 0u; w.y = 0u; *(LAS u32x2*)(PS + i16 * 40 + 16 + 4 * q4) = w; }
        f32x4 ao[2] = {(f32x4){0.f, 0.f, 0.f, 0.f}, (f32x4){0.f, 0.f, 0.f, 0.f}};
#pragma unroll
        for (int ks = 0; ks < 4; ++ks) { const bf16x8 bs = frag((const LAS unsigned char*)ST, 136, 16 * wave + i16, 32 * ks + 8 * q4);
#pragma unroll
            for (int t2 = 0; t2 < 2; ++t2) ao[t2] = MFMA16(frag((const LAS unsigned char*)QT, 136, 16 * t2 + i16, 32 * ks + 8 * q4), bs, ao[t2]); }
        __syncthreads();
        const bf16x8 bv = frag((const LAS unsigned char*)VT, 40, swz8(16 * wave + i16), 8 * q4);
#pragma unroll
        for (int t2 = 0; t2 < 2; ++t2) ao[t2] = MFMA16(frag((const LAS unsigned char*)PS, 40, 16 * t2 + i16, 8 * q4), bv, ao[t2]);
#pragma unroll
        for (int kt2 = 0; kt2 < 8; ++kt2) { const f32x4 gv = *(const LAS f32x4*)(GD + 16 * kt2 + 4 * q4); Sacc[kt2] = Sacc[kt2] * gv;
            Sacc[kt2] = MFMA16(frag((const LAS unsigned char*)KTT, 40, swz8(16 * kt2 + i16), 8 * q4), bv, Sacc[kt2]);
            u32x2 w; w.x = pk2(Sacc[kt2][0], Sacc[kt2][1]); w.y = pk2(Sacc[kt2][2], Sacc[kt2][3]); *(LAS u32x2*)(ST + (16 * wave + i16) * 136 + 16 * kt2 + 4 * q4) = w; }
#pragma unroll
        for (int t2 = 0; t2 < 2; ++t2)
#pragma unroll
            for (int jj = 0; jj < 4; ++jj) OT[(16 * t2 + 4 * q4 + jj) * 136 + 16 * wave + i16] = (bf16_t)f2bf(ao[t2][jj]);
    }
    __syncthreads();
    *(u32x4*)(MIX + (row0 + (size_t)3 * 32 + tt0) * DM + h * 128 + k80) = *(const LAS u32x4*)(OT + tt0 * 136 + k80);
    float* HL = (float*)hsc + (size_t)item * 16384;
    int lane2 = lane; asm volatile("" : "+v"(lane2));
    const int i16 = lane2 & 15, q4 = lane2 >> 4;
#pragma unroll
    for (int kt2 = 0; kt2 < 8; ++kt2)
#pragma unroll
        for (int jj = 0; jj < 4; ++jj) HL[(size_t)(16 * kt2 + 4 * q4 + jj) * 128 + 16 * wave + i16] = Sacc[kt2][jj];
    if (tid < 16) { float* HG = (float*)(hsc + HL_BYTES) + (size_t)item * 128 + tid * 8;
#pragma unroll
        for (int i = 0; i < 8; ++i) HG[i] = __expf(bsum[i]); }
}
__device__ __forceinline__ void hgrn_pass2_unit(int wv, const Params& p, const unsigned char* hsc, int l, int w) {
    const int tid = get_tid(wv);
    const int seq = w >> 2, v = (w & 3) * 32 + (tid & 31), k0 = (tid >> 5) * 8;
    const float* HL = (const float*)hsc; const float* HG = (const float*)(hsc + HL_BYTES); bf16_t* HSIN = (bf16_t*)(p.ws + WS_HSIN);
    float S[8] = {0.f, 0.f, 0.f, 0.f, 0.f, 0.f, 0.f, 0.f};
    for (int cb = 0; cb < 16; cb += 4) {
        float Lv[4][8]; f32x4 g0[4], g1[4];
#pragma unroll
        for (int u = 0; u < 4; ++u) { const size_t item = (size_t)seq * 16 + cb + u;
#pragma unroll
            for (int i = 0; i < 8; ++i) Lv[u][i] = HL[item * 16384 + (size_t)(k0 + i) * 128 + v];
            g0[u] = *(const f32x4*)(HG + item * 128 + k0); g1[u] = *(const f32x4*)(HG + item * 128 + k0 + 4); }
#pragma unroll
        for (int u = 0; u < 4; ++u) { const size_t item = (size_t)seq * 16 + cb + u;
            u32x4 wv4; wv4.x = pk2(S[0], S[1]); wv4.y = pk2(S[2], S[3]); wv4.z = pk2(S[4], S[5]); wv4.w = pk2(S[6], S[7]);
            *(u32x4*)(HSIN + item * 16384 + (size_t)v * 128 + k0) = wv4;
#pragma unroll
            for (int i = 0; i < 4; ++i) { S[i] = g0[u][i] * S[i] + Lv[u][i]; S[4 + i] = g1[u][i] * S[4 + i] + Lv[u][4 + i]; } }
    }
    float* HP = p.out + O_HP + ((size_t)l * 64 + seq) * 16384;
#pragma unroll
    for (int i = 0; i < 8; ++i) HP[(size_t)(k0 + i) * 128 + v] = S[i];
}
constexpr int P3_ST = 0, P3_QT = 34816, P3_OSS = 69632, P3_OL = 73728, P3_GT = 108544;
static_assert(P3_GT + 34816 <= LDS_ST_OFF, "pass 3 lds");
__device__ __forceinline__ void hgrn_pass3_item(int wv, const Params& p, int l, int item, LAS unsigned char* lds) {
    const int tid = get_tid(wv); const int lane = tid & 63, wave = __builtin_amdgcn_readfirstlane(tid >> 6), i16 = lane & 15, q4 = lane >> 4;
    const int c = item & 15, h = (item >> 4) & 7, b = item >> 7;
    const bf16_t* Z = (const bf16_t*)(p.ws + WS_Z); bf16_t* MIX = (bf16_t*)(p.ws + WS_MIX); const bf16_t* HSIN = (const bf16_t*)(p.ws + WS_HSIN) + (size_t)item * 16384;
    LAS bf16_t* ST = (LAS bf16_t*)(lds + P3_ST); LAS bf16_t* QT = (LAS bf16_t*)(lds + P3_QT); LAS float* OSS = (LAS float*)(lds + P3_OSS);
    LAS bf16_t* OL = (LAS bf16_t*)(lds + P3_OL); LAS bf16_t* GT = (LAS bf16_t*)(lds + P3_GT);
    const size_t row0 = (size_t)b * SEQ + (size_t)c * 128;
    const int rr = tid >> 2, part = (tid & 3) * 32;
    __syncthreads();
    { u32x4 t0[4], t1[4], t2[4], t3[4];
#pragma unroll
      for (int i = 0; i < 4; ++i) { t0[i] = *(const u32x4*)(HSIN + (size_t)rr * 128 + part + 8 * i); t1[i] = *(const u32x4*)(Z + (row0 + rr) * DIN + ZQ + h * 128 + part + 8 * i);
          t2[i] = *(const u32x4*)(MIX + (row0 + rr) * DM + h * 128 + part + 8 * i); t3[i] = *(const u32x4*)(Z + (row0 + rr) * DIN + ZG + h * 128 + part + 8 * i); }
#pragma unroll
      for (int i = 0; i < 4; ++i) { *(LAS u32x4*)(ST + rr * 136 + part + 8 * i) = t0[i]; *(LAS u32x4*)(QT + rr * 136 + part + 8 * i) = t1[i];
          *(LAS u32x4*)(OL + rr * 136 + part + 8 * i) = t2[i]; *(LAS u32x4*)(GT + rr * 136 + part + 8 * i) = t3[i]; } }
    __syncthreads();
    const int vl = 16 * wave + i16;
    f32x4 ao[8];
#pragma unroll
    for (int t2 = 0; t2 < 8; ++t2) ao[t2] = (f32x4){0.f, 0.f, 0.f, 0.f};
#pragma unroll
    for (int ks = 0; ks < 4; ++ks) { const bf16x8 bs = frag((const LAS unsigned char*)ST, 136, 16 * wave + i16, 32 * ks + 8 * q4);
#pragma unroll
        for (int t2 = 0; t2 < 8; ++t2) ao[t2] = MFMA16(frag((const LAS unsigned char*)QT, 136, 16 * t2 + i16, 32 * ks + 8 * q4), bs, ao[t2]); }
#pragma unroll
    for (int t2 = 0; t2 < 8; ++t2)
#pragma unroll
        for (int jj = 0; jj < 4; ++jj) { const int t = 16 * t2 + 4 * q4 + jj;
            ao[t2][jj] += bf2f(OL[t * 136 + vl]);
            float s = ao[t2][jj] * ao[t2][jj]; s += __shfl_xor(s, 1); s += __shfl_xor(s, 2); s += __shfl_xor(s, 4); s += __shfl_xor(s, 8);
            if (i16 == 0) OSS[t * 8 + wave] = s; }
    __syncthreads();
    const float ngv = p.in[11][l * 128 + vl];
#pragma unroll
    for (int t2 = 0; t2 < 8; ++t2)
#pragma unroll
        for (int jj = 0; jj < 4; ++jj) { const int t = 16 * t2 + 4 * q4 + jj; const f32x4 pa = *(const LAS f32x4*)(OSS + t * 8), pc = *(const LAS f32x4*)(OSS + t * 8 + 4);
            const float rstd = rsqrtf((((pa[0] + pa[1]) + (pa[2] + pa[3])) + ((pc[0] + pc[1]) + (pc[2] + pc[3]))) * (1.0f / 128.0f) + EPS);
            OL[t * 136 + vl] = (bf16_t)f2bf(ao[t2][jj] * rstd * ngv * bf2f(GT[t * 136 + vl])); }
    __syncthreads();
#pragma unroll
    for (int i = 0; i < 4; ++i) *(u32x4*)(MIX + (row0 + rr) * DM + h * 128 + part + 8 * i) = *(const LAS u32x4*)(OL + rr * 136 + part + 8 * i);
}
__device__ __forceinline__ void hgrn_sample_item(int wv, const Params& p, int l, int s, LAS unsigned char* lds) {
    const int tid = get_tid(wv); const int lane = tid & 63, h = __builtin_amdgcn_readfirstlane(tid >> 6);
    const bf16_t* Z = (const bf16_t*)(p.ws + WS_Z); const float* LF = (const float*)(p.ws + WS_LF); bf16_t* MIX = (bf16_t*)(p.ws + WS_MIX);
    LAS float* FQ = (LAS float*)(lds + h * 2048);
    const size_t r = (size_t)MPR + s;
    __syncthreads();
#pragma unroll
    for (int i = 0; i < 2; ++i) { const int k = lane + 64 * i; const float lf = LF[r * 1024 + h * 128 + k];
        FQ[k] = __expf(lf); FQ[128 + k] = -expm1f(lf); FQ[256 + k] = bf2f(Z[r * DIN + ZQ + h * 128 + k]); }
    asm volatile("s_waitcnt lgkmcnt(0)" ::: "memory");
    const int hl = lane & 31, kh = lane >> 5;
    const u32x2 vw = *(const u32x2*)(Z + r * DIN + ZI + h * 128 + 4 * hl);
    const f32x4 vv = (f32x4){lo16(vw.x), hi16(vw.x), lo16(vw.y), hi16(vw.y)};
    const float* S0 = p.in[2] + (((size_t)l * NSAMP + s) * 8 + h) * 16384;
    float* S1 = p.out + O_HS + (((size_t)l * NSAMP + s) * 8 + h) * 16384;
    f32x4 o = (f32x4){0.f, 0.f, 0.f, 0.f};
    for (int kb = 0; kb < 128; kb += 32) {
        f32x4 sv[16];
#pragma unroll
        for (int u = 0; u < 16; ++u) sv[u] = *(const f32x4*)(S0 + (size_t)(kb + 2 * u + kh) * 128 + 4 * hl);
#pragma unroll
        for (int u = 0; u < 16; ++u) { const int k = kb + 2 * u + kh; const float f = FQ[k], kk = FQ[128 + k], q = FQ[256 + k];
            const f32x4 sn = sv[u] * f + vv * kk; *(f32x4*)(S1 + (size_t)k * 128 + 4 * hl) = sn; o += sn * q; }
    }
#pragma unroll
    for (int j = 0; j < 4; ++j) o[j] += __shfl_xor(o[j], 32);
    const float rstd = rsqrtf(wave_sum((o[0] * o[0] + o[1] * o[1]) + (o[2] * o[2] + o[3] * o[3])) * (0.5f / 128.0f) + EPS);
    const u32x2 gw = *(const u32x2*)(Z + r * DIN + ZG + h * 128 + 4 * hl);
    const f32x4 ng = *(const f32x4*)(p.in[11] + l * 128 + 4 * hl);
    if (kh == 0) { u32x2 w; w.x = pk2(o[0] * rstd * ng[0] * lo16(gw.x), o[1] * rstd * ng[1] * hi16(gw.x)); w.y = pk2(o[2] * rstd * ng[2] * lo16(gw.y), o[3] * rstd * ng[3] * hi16(gw.y));
        *(u32x2*)(MIX + r * DM + h * 128 + 4 * hl) = w; }
}
constexpr int SW_KN = 0;
constexpr int SW_VT = 36864;
constexpr int SW_PS = SW_VT + 33792;
static_assert(SW_PS + 8 * 8448 <= LDS_BYTES, "swa lds");
__device__ __forceinline__ void swa_prompt_item(int wv, const Params& p, int l, int item, LAS unsigned char* lds) {
    const int tid = get_tid(wv); const int lane = tid & 63, wave = __builtin_amdgcn_readfirstlane(tid >> 6), i16 = lane & 15, q4 = lane >> 4;
    const int kvh = item & 1, nb = (item >> 1) & 15, b = item >> 5;
    const bf16_t* Z = (const bf16_t*)(p.ws + WS_Z); bf16_t* MIX = (bf16_t*)(p.ws + WS_MIX);
    LAS bf16_t* KN = (LAS bf16_t*)(lds + SW_KN); LAS bf16_t* VT = (LAS bf16_t*)(lds + SW_VT); LAS bf16_t* PS = (LAS bf16_t*)(lds + SW_PS + wave * 8448);
    __syncthreads();
    {
        const int key = tid >> 1, half = tid & 1;
        const int pos = (nb - 1) * 128 + key;
        float kv[32], vv[32];
        if (pos >= 0) {
            const size_t r = (size_t)b * SEQ + pos;
#pragma unroll
            for (int i = 0; i < 4; ++i) { const u32x4 kw = *(const u32x4*)(Z + r * DIN + ZSK + kvh * 64 + 32 * half + 8 * i), vw = *(const u32x4*)(Z + r * DIN + ZSV + kvh * 64 + 32 * half + 8 * i);
                kv[8 * i + 0] = lo16(kw.x); kv[8 * i + 1] = hi16(kw.x); kv[8 * i + 2] = lo16(kw.y); kv[8 * i + 3] = hi16(kw.y); kv[8 * i + 4] = lo16(kw.z); kv[8 * i + 5] = hi16(kw.z); kv[8 * i + 6] = lo16(kw.w); kv[8 * i + 7] = hi16(kw.w);
                vv[8 * i + 0] = lo16(vw.x); vv[8 * i + 1] = hi16(vw.x); vv[8 * i + 2] = lo16(vw.y); vv[8 * i + 3] = hi16(vw.y); vv[8 * i + 4] = lo16(vw.z); vv[8 * i + 5] = hi16(vw.z); vv[8 * i + 6] = lo16(vw.w); vv[8 * i + 7] = hi16(vw.w); }
        } else {
#pragma unroll
            for (int i = 0; i < 32; ++i) { kv[i] = 0.f; vv[i] = 0.f; }
        }
        float ss = 0.f;
#pragma unroll
        for (int i = 0; i < 32; ++i) ss += kv[i] * kv[i];
        ss += __shfl_xor(ss, 1);
        const float rstd = rsqrtf(ss * (1.0f / 64.0f) + EPS);
        const float* kg = p.in[13] + l * 64 + 32 * half;
#pragma unroll
        for (int i = 0; i < 32; ++i) kv[i] = kv[i] * rstd * kg[i];
#pragma unroll
        for (int i = 0; i < 4; ++i) { u32x4 w; w.x = pk2(kv[8 * i], kv[8 * i + 1]); w.y = pk2(kv[8 * i + 2], kv[8 * i + 3]); w.z = pk2(kv[8 * i + 4], kv[8 * i + 5]); w.w = pk2(kv[8 * i + 6], kv[8 * i + 7]);
            *(LAS u32x4*)(KN + key * 72 + 32 * half + 8 * i) = w; }
#pragma unroll
        for (int i = 0; i < 32; ++i) VT[(32 * half + i) * 264 + key] = (bf16_t)f2bf(vv[i]);
        if (nb == 15 && key >= 128) {
            float* kd = p.out + O_KP + ((((size_t)l * 8 + b) * 128 + (key - 128)) * 2 + kvh) * 64 + 32 * half;
            float* vd = p.out + O_VP + ((((size_t)l * 8 + b) * 128 + (key - 128)) * 2 + kvh) * 64 + 32 * half;
#pragma unroll
            for (int i = 0; i < 8; ++i) { *(f32x4*)(kd + 4 * i) = (f32x4){kv[4 * i], kv[4 * i + 1], kv[4 * i + 2], kv[4 * i + 3]}; *(f32x4*)(vd + 4 * i) = (f32x4){vv[4 * i], vv[4 * i + 1], vv[4 * i + 2], vv[4 * i + 3]}; }
        }
    }
    __syncthreads();
    const int g = wave >> 1, ph = wave & 1, hq = kvh * 4 + g;
    const float sink = p.in[14][l * 8 + hq];
    u32x4 qraw[4][2];
#pragma unroll
    for (int mt = 0; mt < 4; ++mt) { const size_t rq = (size_t)b * SEQ + nb * 128 + 64 * ph + 16 * mt + i16;
        qraw[mt][0] = *(const u32x4*)(Z + rq * DIN + ZSQ + hq * 64 + 8 * q4); qraw[mt][1] = *(const u32x4*)(Z + rq * DIN + ZSQ + hq * 64 + 32 + 8 * q4); }
#pragma unroll
    for (int mt = 0; mt < 4; ++mt) {
        const int qi = 64 * ph + 16 * mt + i16;
        bf16x8 qf[2];
        {
            const u32x4 w0 = qraw[mt][0], w1 = qraw[mt][1];
            float a[16] = {lo16(w0.x), hi16(w0.x), lo16(w0.y), hi16(w0.y), lo16(w0.z), hi16(w0.z), lo16(w0.w), hi16(w0.w), lo16(w1.x), hi16(w1.x), lo16(w1.y), hi16(w1.y), lo16(w1.z), hi16(w1.z), lo16(w1.w), hi16(w1.w)};
            float ss = 0.f;
#pragma unroll
            for (int i = 0; i < 16; ++i) ss += a[i] * a[i];
            ss += __shfl_xor(ss, 16); ss += __shfl_xor(ss, 32);
            const float sc = rsqrtf(ss * (1.0f / 64.0f) + EPS) * 0.125f;
            const float* qg = p.in[12] + l * 64;
#pragma unroll
            for (int i = 0; i < 8; ++i) { a[i] *= sc * qg[8 * q4 + i]; a[8 + i] *= sc * qg[32 + 8 * q4 + i]; }
            u32x4 f0, f1; f0.x = pk2(a[0], a[1]); f0.y = pk2(a[2], a[3]); f0.z = pk2(a[4], a[5]); f0.w = pk2(a[6], a[7]); f1.x = pk2(a[8], a[9]); f1.y = pk2(a[10], a[11]); f1.z = pk2(a[12], a[13]); f1.w = pk2(a[14], a[15]);
            qf[0] = __builtin_bit_cast(bf16x8, f0); qf[1] = __builtin_bit_cast(bf16x8, f1);
        }
        f32x4 sc_[16];
        float mx = -3.0e38f;
#pragma unroll
        for (int kt = 0; kt < 16; ++kt) { f32x4 a = (f32x4){0.f, 0.f, 0.f, 0.f};
            a = MFMA16(frag((const LAS unsigned char*)KN, 72, 16 * kt + i16, 8 * q4), qf[0], a);
            a = MFMA16(frag((const LAS unsigned char*)KN, 72, 16 * kt + i16, 32 + 8 * q4), qf[1], a);
#pragma unroll
            for (int jj = 0; jj < 4; ++jj) { const int kj = 16 * kt + 4 * q4 + jj; const bool ok = (kj > qi) && (kj <= qi + 128) && (nb > 0 || kj >= 128);
                a[jj] = ok ? a[jj] : -3.0e38f; mx = fmaxf(mx, a[jj]); }
            sc_[kt] = a; }
        mx = fmaxf(mx, __shfl_xor(mx, 16)); mx = fmaxf(mx, __shfl_xor(mx, 32)); mx = fmaxf(mx, sink);
        float sum = 0.f;
#pragma unroll
        for (int kt = 0; kt < 16; ++kt)
#pragma unroll
            for (int jj = 0; jj < 4; ++jj) { const float e = (sc_[kt][jj] > -1.0e38f) ? __expf(sc_[kt][jj] - mx) : 0.f; sc_[kt][jj] = e; sum += e; }
        sum += __shfl_xor(sum, 16); sum += __shfl_xor(sum, 32);
        const float inv = 1.0f / (sum + __expf(sink - mx));
#pragma unroll
        for (int kt = 0; kt < 16; ++kt) { u32x2 w; w.x = pk2(sc_[kt][0] * inv, sc_[kt][1] * inv); w.y = pk2(sc_[kt][2] * inv, sc_[kt][3] * inv); *(LAS u32x2*)(PS + i16 * 264 + 16 * kt + 4 * q4) = w; }
        asm volatile("s_waitcnt lgkmcnt(0)" ::: "memory");
        f32x4 ao[4];
#pragma unroll
        for (int dt = 0; dt < 4; ++dt) ao[dt] = (f32x4){0.f, 0.f, 0.f, 0.f};
#pragma unroll
        for (int ks = 0; ks < 8; ++ks) { const bf16x8 pa = frag((const LAS unsigned char*)PS, 264, i16, 32 * ks + 8 * q4);
#pragma unroll
            for (int dt = 0; dt < 4; ++dt) ao[dt] = MFMA16(pa, frag((const LAS unsigned char*)VT, 264, 16 * dt + i16, 32 * ks + 8 * q4), ao[dt]); }
        asm volatile("s_waitcnt lgkmcnt(0)" ::: "memory");
#pragma unroll
        for (int dt = 0; dt < 4; ++dt)
#pragma unroll
            for (int jj = 0; jj < 4; ++jj) { const size_t ro = (size_t)b * SEQ + nb * 128 + 64 * ph + 16 * mt + 4 * q4 + jj;
                MIX[ro * DM + 1024 + hq * 64 + 16 * dt + i16] = (bf16_t)f2bf(ao[dt][jj]); }
    }
}
constexpr int SD_KL = 0;
constexpr int SD_VL = 66560;
constexpr int SD_QN = 133120;
constexpr int SD_KV = SD_QN + 2048;
constexpr int SD_PL = SD_KV + 1024;
static_assert(SD_PL + 4096 <= LDS_BYTES, "swa dec lds");
__device__ __forceinline__ void swa_sample_item(int wv, const Params& p, int l, int s, LAS unsigned char* lds) {
    const int tid = get_tid(wv); const int lane = tid & 63, wave = __builtin_amdgcn_readfirstlane(tid >> 6);
    const bf16_t* Z = (const bf16_t*)(p.ws + WS_Z); bf16_t* MIX = (bf16_t*)(p.ws + WS_MIX);
    LAS float* KL = (LAS float*)(lds + SD_KL); LAS float* VL = (LAS float*)(lds + SD_VL); LAS float* QN = (LAS float*)(lds + SD_QN);
    LAS float* KVN = (LAS float*)(lds + SD_KV); LAS float* PL = (LAS float*)(lds + SD_PL);
    const size_t r = (size_t)MPR + s;
    __syncthreads();
    { const float q = bf2f(Z[r * DIN + ZSQ + wave * 64 + lane]); const float rstd = rsqrtf(wave_sum(q * q) * (1.0f / 64.0f) + EPS); QN[wave * 64 + lane] = q * rstd * p.in[12][l * 64 + lane] * 0.125f; }
    if (wave < 2) { const float k = bf2f(Z[r * DIN + ZSK + wave * 64 + lane]); const float rstd = rsqrtf(wave_sum(k * k) * (1.0f / 64.0f) + EPS);
        KVN[wave * 64 + lane] = k * rstd * p.in[13][l * 64 + lane]; KVN[128 + wave * 64 + lane] = bf2f(Z[r * DIN + ZSV + wave * 64 + lane]); }
    __syncthreads();
    const float* ck = p.in[3] + ((size_t)l * NSAMP + s) * 128 * 128; const float* cv = p.in[4] + ((size_t)l * NSAMP + s) * 128 * 128;
    float* ko = p.out + O_KS + ((size_t)l * NSAMP + s) * 128 * 128; float* vo = p.out + O_VS + ((size_t)l * NSAMP + s) * 128 * 128;
    for (int base = 0; base < 16384; base += 8 * 512) {
        float kx[8], vx[8];
#pragma unroll
        for (int u = 0; u < 8; ++u) { const int idx = base + u * 512 + tid, i = idx >> 7, rem = idx & 127;
            kx[u] = (i < 127) ? ck[(i + 1) * 128 + rem] : KVN[rem]; vx[u] = (i < 127) ? cv[(i + 1) * 128 + rem] : KVN[128 + rem]; }
#pragma unroll
        for (int u = 0; u < 8; ++u) { const int idx = base + u * 512 + tid, i = idx >> 7, rem = idx & 127, kvh = rem >> 6, d = rem & 63;
            ko[idx] = kx[u]; vo[idx] = vx[u]; KL[(kvh * 128 + i) * 65 + d] = kx[u]; VL[(kvh * 128 + i) * 65 + d] = vx[u]; }
    }
    __syncthreads();
    const int hq = wave, kvh = hq >> 2;
    const float sink = p.in[14][l * 8 + hq];
    float s0 = 0.f, s1 = 0.f;
#pragma unroll 8
    for (int d = 0; d < 64; ++d) { const float q = QN[hq * 64 + d]; s0 += q * KL[(kvh * 128 + lane) * 65 + d]; s1 += q * KL[(kvh * 128 + 64 + lane) * 65 + d]; }
    const float mx = fmaxf(wave_max(fmaxf(s0, s1)), sink);
    const float e0 = __expf(s0 - mx), e1 = __expf(s1 - mx);
    const float inv = 1.0f / (wave_sum(e0 + e1) + __expf(sink - mx));
    PL[hq * 128 + lane] = e0 * inv; PL[hq * 128 + 64 + lane] = e1 * inv;
    asm volatile("s_waitcnt lgkmcnt(0)" ::: "memory");
    float o = 0.f;
#pragma unroll 8
    for (int i = 0; i < 128; ++i) o += PL[hq * 128 + i] * VL[(kvh * 128 + i) * 65 + lane];
    MIX[r * DM + 1024 + hq * 64 + lane] = (bf16_t)f2bf(o);
}
constexpr int GM_WL = 0;
constexpr int GM_VN = 34816;
constexpr int GM_ST = 69632;
static_assert(GM_ST + 1024 <= LDS_BYTES, "gmlp lds");
__device__ __forceinline__ void gmlp_prompt_item(int wv, const Params& p, int l, int item, LAS unsigned char* lds) {
    const int tid = get_tid(wv); const int lane = tid & 63, wave = __builtin_amdgcn_readfirstlane(tid >> 6), i16 = lane & 15, q4 = lane >> 4;
    const bf16_t* Z = (const bf16_t*)(p.ws + WS_Z); bf16_t* MIX = (bf16_t*)(p.ws + WS_MIX);
    LAS bf16_t* WL = (LAS bf16_t*)(lds + GM_WL); LAS bf16_t* VN = (LAS bf16_t*)(lds + GM_VN); LAS float* STAT = (LAS float*)(lds + GM_ST);
    const size_t r0 = (size_t)item * 128;
    __syncthreads();
    for (int i = 0; i < 16; ++i) { const int q = 16 * wave + i; const u32x4 w = *(const u32x4*)(Z + (r0 + q) * DIN + ZVR + 8 * lane);
        const float a[8] = {lo16(w.x), hi16(w.x), lo16(w.y), hi16(w.y), lo16(w.z), hi16(w.z), lo16(w.w), hi16(w.w)};
        float s = 0.f, s2 = 0.f;
#pragma unroll
        for (int k = 0; k < 8; ++k) { s += a[k]; s2 += a[k] * a[k]; }
        s = wave_sum(s); s2 = wave_sum(s2);
        const float mean = s * (1.0f / 512.0f), var = fmaxf(s2 * (1.0f / 512.0f) - mean * mean, 0.f);
        if (lane == 0) { STAT[q] = mean; STAT[128 + q] = rsqrtf(var + EPS); } }
    for (int g = 0; g < 4; ++g) {
        __syncthreads();
        {
            const int pr = tid >> 2, qq = (tid & 3) * 32;
            const float* wsrc = p.in[17] + (((size_t)l * 4 + g) * 128 + pr) * 128 + qq;
#pragma unroll
            for (int i = 0; i < 4; ++i) { const f32x4 a = *(const f32x4*)(wsrc + 8 * i), c = *(const f32x4*)(wsrc + 8 * i + 4); const int q0 = qq + 8 * i;
                u32x4 w; w.x = pk2(q0 <= pr ? a[0] : 0.f, q0 + 1 <= pr ? a[1] : 0.f); w.y = pk2(q0 + 2 <= pr ? a[2] : 0.f, q0 + 3 <= pr ? a[3] : 0.f);
                w.z = pk2(q0 + 4 <= pr ? c[0] : 0.f, q0 + 5 <= pr ? c[1] : 0.f); w.w = pk2(q0 + 6 <= pr ? c[2] : 0.f, q0 + 7 <= pr ? c[3] : 0.f);
                *(LAS u32x4*)(WL + pr * 136 + q0) = w; }
            const int q = tid >> 2, cc = (tid & 3) * 32;
            const float mean = STAT[q], rstd = STAT[128 + q];
            const float* lg = p.in[15] + l * 512 + g * 128 + cc; const float* lbb = p.in[16] + l * 512 + g * 128 + cc;
#pragma unroll
            for (int i = 0; i < 4; ++i) { const u32x4 w = *(const u32x4*)(Z + (r0 + q) * DIN + ZVR + g * 128 + cc + 8 * i);
                const float a[8] = {lo16(w.x), hi16(w.x), lo16(w.y), hi16(w.y), lo16(w.z), hi16(w.z), lo16(w.w), hi16(w.w)};
#pragma unroll
                for (int k = 0; k < 8; ++k) VN[(cc + 8 * i + k) * 136 + q] = (bf16_t)f2bf((a[k] - mean) * rstd * lg[8 * i + k] + lbb[8 * i + k]); }
        }
        __syncthreads();
        f32x4 acc[8];
#pragma unroll
        for (int ct = 0; ct < 8; ++ct) acc[ct] = (f32x4){0.f, 0.f, 0.f, 0.f};
        const int ksmax = (16 * wave + 15) >> 5;
        for (int ks = 0; ks <= ksmax; ++ks) { const bf16x8 wb = frag((const LAS unsigned char*)WL, 136, 16 * wave + i16, 32 * ks + 8 * q4);
#pragma unroll
            for (int ct = 0; ct < 8; ++ct) acc[ct] = MFMA16(frag((const LAS unsigned char*)VN, 136, 16 * ct + i16, 32 * ks + 8 * q4), wb, acc[ct]); }
        const int pr = 16 * wave + i16;
        const float bsv = p.in[18][((size_t)l * 4 + g) * 128 + pr];
        u32x2 uwv[8];
#pragma unroll
        for (int ct = 0; ct < 8; ++ct) uwv[ct] = *(const u32x2*)(Z + (r0 + pr) * DIN + ZU + g * 128 + 16 * ct + 4 * q4);
#pragma unroll
        for (int ct = 0; ct < 8; ++ct) { const int c = g * 128 + 16 * ct + 4 * q4;
            const u32x2 uw = uwv[ct];
            u32x2 w; w.x = pk2(lo16(uw.x) * (acc[ct][0] + bsv), hi16(uw.x) * (acc[ct][1] + bsv)); w.y = pk2(lo16(uw.y) * (acc[ct][2] + bsv), hi16(uw.y) * (acc[ct][3] + bsv));
            *(u32x2*)(MIX + (r0 + pr) * DM + 1536 + c) = w; }
    }
}
__device__ __forceinline__ void gmlp_sample_item(int wv, const Params& p, int l, int item) {
    const int tid = get_tid(wv); const int lane = tid & 63, wave = __builtin_amdgcn_readfirstlane(tid >> 6);
    const bf16_t* Z = (const bf16_t*)(p.ws + WS_Z); bf16_t* MIX = (bf16_t*)(p.ws + WS_MIX);
    const int s = item * 8 + wave; const size_t r = (size_t)MPR + s;
    const u32x4 w = *(const u32x4*)(Z + r * DIN + ZVR + 8 * lane), uw = *(const u32x4*)(Z + r * DIN + ZU + 8 * lane);
    const float a[8] = {lo16(w.x), hi16(w.x), lo16(w.y), hi16(w.y), lo16(w.z), hi16(w.z), lo16(w.w), hi16(w.w)};
    const float uu[8] = {lo16(uw.x), hi16(uw.x), lo16(uw.y), hi16(uw.y), lo16(uw.z), hi16(uw.z), lo16(uw.w), hi16(uw.w)};
    float sm = 0.f, s2 = 0.f;
#pragma unroll
    for (int k = 0; k < 8; ++k) { sm += a[k]; s2 += a[k] * a[k]; }
    sm = wave_sum(sm); s2 = wave_sum(s2);
    const float mean = sm * (1.0f / 512.0f), rstd = rsqrtf(fmaxf(s2 * (1.0f / 512.0f) - mean * mean, 0.f) + EPS);
    const int g = lane >> 4;
    const float w00 = p.in[17][((size_t)l * 4 + g) * 16384], b0 = p.in[18][((size_t)l * 4 + g) * 128];
    float vn[8], o[8];
#pragma unroll
    for (int k = 0; k < 8; ++k) { vn[k] = (a[k] - mean) * rstd * p.in[15][l * 512 + 8 * lane + k] + p.in[16][l * 512 + 8 * lane + k]; o[k] = uu[k] * (w00 * vn[k] + b0); }
    float* gs = p.out + O_GS + ((size_t)l * NSAMP + s) * 512 + 8 * lane;
    *(f32x4*)gs = (f32x4){vn[0], vn[1], vn[2], vn[3]}; *(f32x4*)(gs + 4) = (f32x4){vn[4], vn[5], vn[6], vn[7]};
    u32x4 ow; ow.x = pk2(o[0], o[1]); ow.y = pk2(o[2], o[3]); ow.z = pk2(o[4], o[5]); ow.w = pk2(o[6], o[7]);
    *(u32x4*)(MIX + r * DM + 1536 + 8 * lane) = ow;
}
__device__ __forceinline__ void mixer_other(int wv, const Params& p, int l, int it, LAS unsigned char* lds) {
#ifndef MXM
#define MXM 0xff
#endif
    if (it < 256) { if (MXM & 1) swa_prompt_item(wv, p, l, it, lds); }
    else if (it < 384) { if (MXM & 2) gmlp_prompt_item(wv, p, l, it - 256, lds); }
    else if (it < 512) { if (MXM & 4) hgrn_sample_item(wv, p, l, it - 384, lds); }
    else if (it < 528) { if (MXM & 16) gmlp_sample_item(wv, p, l, it - 512); }
    else if (it < 640) { }
    else { if (MXM & 8) swa_sample_item(wv, p, l, it - 640, lds); }
}
__device__ __forceinline__ void phase_mixers(int wv, const Params& p, unsigned char* hsc, int l, LAS unsigned char* lds) {
    const int G = gridDim.x, bid = blockIdx.x;
    constexpr int NOTHER = 768;
    for (int it = bid; it < 1024 + NOTHER; it += G) {
        if (it < 1024) hgrn_pass1_item(wv, p, hsc, l, it, lds);
        else mixer_other(wv, p, l, it - 1024, lds);
    }
}
__device__ __forceinline__ void phase_hgrn2(int wv, const Params& p, const unsigned char* hsc, int l) {
    for (int w = blockIdx.x; w < 256; w += gridDim.x) hgrn_pass2_unit(wv, p, hsc, l, w);
}
__device__ __forceinline__ void phase_hgrn3(int wv, const Params& p, int l, LAS unsigned char* lds) {
    for (int it = blockIdx.x; it < 1024; it += gridDim.x) hgrn_pass3_item(wv, p, l, it, lds);
}
__device__ __forceinline__ void phase_fixup(int wv, const Params& p, int l) {
    const bf16_t* SIDE = (const bf16_t*)(p.ws + WS_SIDE); bf16_t* ACT = (bf16_t*)(p.ws + WS_ACT);
    const float* cw = p.in[22] + (size_t)l * 3 * DFF2; const float* cb = p.in[23] + (size_t)l * DFF2;
    const int NT = gridDim.x * 512;
    constexpr int CG8 = DFF / 8;
    const int ftid = get_tid(wv);
    for (int i = blockIdx.x * 512 + ftid; i < 256 * 2 * CG8; i += NT) {
        const int c = (i % CG8) * 8, sr = i / CG8, rho = sr & 1, s = sr >> 1;
        const int r = 64 * s + rho; const bool first = (s & 31) == 0;
        const bf16_t* cur = SIDE + ((size_t)s * 4 + 2 + rho) * DFF2;
        const bf16_t* p1 = rho ? SIDE + ((size_t)s * 4 + 2) * DFF2 : SIDE + ((size_t)(s - 1) * 4 + 1) * DFF2;
        const bf16_t* p2 = rho ? SIDE + ((size_t)(s - 1) * 4 + 1) * DFF2 : SIDE + ((size_t)(s - 1) * 4 + 0) * DFF2;
        const bool z1 = first && rho == 0, z2 = first;
        float o[8];
#pragma unroll
        for (int hv = 0; hv < 2; ++hv) {
            const int cc = c + hv * DFF;
            const u32x4 x0 = *(const u32x4*)(cur + cc);
            u32x4 x1 = (u32x4){0u, 0u, 0u, 0u}, x2 = x1;
            if (!z1) x1 = *(const u32x4*)(p1 + cc);
            if (!z2) x2 = *(const u32x4*)(p2 + cc);
            const unsigned a0[4] = {x0.x, x0.y, x0.z, x0.w}, a1[4] = {x1.x, x1.y, x1.z, x1.w}, a2[4] = {x2.x, x2.y, x2.z, x2.w};
#pragma unroll
            for (int k = 0; k < 8; ++k) {
                const float v0 = (k & 1) ? hi16(a0[k >> 1]) : lo16(a0[k >> 1]), v1 = (k & 1) ? hi16(a1[k >> 1]) : lo16(a1[k >> 1]), v2 = (k & 1) ? hi16(a2[k >> 1]) : lo16(a2[k >> 1]);
                const float cv = cb[cc + k] + cw[cc + k] * v2 + cw[DFF2 + cc + k] * v1 + cw[2 * DFF2 + cc + k] * v0;
                o[k] = hv ? o[k] * cv : fsilu(cv);
            }
        }
        u32x4 w; w.x = pk2(o[0], o[1]); w.y = pk2(o[2], o[3]); w.z = pk2(o[4], o[5]); w.w = pk2(o[6], o[7]);
        *(u32x4*)(ACT + (size_t)r * DFF + c) = w;
    }
    float* conv_s = p.out + O_CS + (size_t)l * NSAMP * 2 * DFF2; const float* cstate = p.in[5] + (size_t)l * NSAMP * 2 * DFF2;
    for (int i = blockIdx.x * 512 + ftid; i < NSAMP * (DFF / 4); i += NT) {
        const int c = (i % (DFF / 4)) * 4, sidx = i / (DFF / 4);
        const float* st0 = cstate + (size_t)sidx * 2 * DFF2, * st1 = st0 + DFF2; float* d0 = conv_s + (size_t)sidx * 2 * DFF2, * d1 = d0 + DFF2;
        const f32x4 g2 = *(const f32x4*)(st0 + c), g1 = *(const f32x4*)(st1 + c), v2 = *(const f32x4*)(st0 + DFF + c), v1 = *(const f32x4*)(st1 + DFF + c);
        const f32x4 xg = *(const f32x4*)(d1 + c), xv = *(const f32x4*)(d1 + DFF + c);
        f32x4 o;
#pragma unroll
        for (int j = 0; j < 4; ++j) {
            const float cg_ = cb[c + j] + cw[c + j] * g2[j] + cw[DFF2 + c + j] * g1[j] + cw[2 * DFF2 + c + j] * xg[j];
            const float cv_ = cb[DFF + c + j] + cw[DFF + c + j] * v2[j] + cw[DFF2 + DFF + c + j] * v1[j] + cw[2 * DFF2 + DFF + c + j] * xv[j];
            o[j] = fsilu(cg_) * cv_;
        }
        u32x2 w; w.x = pk2(o[0], o[1]); w.y = pk2(o[2], o[3]); *(u32x2*)(ACT + (size_t)(MPR + sidx) * DFF + c) = w;
        *(f32x4*)(d0 + c) = g1; *(f32x4*)(d0 + DFF + c) = v1;
    }
}

#ifndef PHM
#define PHM 0xff
#endif
#define XB_TMO      128
#define XB_XCNT(j)  (256  + 64 * (j))
#define XB_XSUB(j)  (1280 + 64 * (j))
#define XB_XGEN(j)  (2304 + 64 * (j))
#define XB_TOP      3328
#define XB_TOPGEN   3392
#define XCD_BAR_WORDS 3456
#define XB_SPIN_CAP (1u << 18)

__device__ __forceinline__ unsigned xb_ld(unsigned* p)              { return __hip_atomic_load(p, __ATOMIC_RELAXED, __HIP_MEMORY_SCOPE_AGENT); }
__device__ __forceinline__ unsigned xb_add(unsigned* p, unsigned v) { return __hip_atomic_fetch_add(p, v, __ATOMIC_RELAXED, __HIP_MEMORY_SCOPE_AGENT); }
__device__ __forceinline__ unsigned xb_xcc_id() { return (unsigned)__builtin_amdgcn_s_getreg((3 << 11) | 20) & 0xFu; }
#define XB_SPIN(cond, bar) do { unsigned _sp = 0; while (cond) { __builtin_amdgcn_s_sleep(1); \
    if ((++_sp & 255u) == 0u) { if (xb_ld(&(bar)[XB_TMO])) break; if (_sp > XB_SPIN_CAP) { atomicAdd(&(bar)[XB_TMO], 1u); break; } } } } while (0)

struct XcdBarrier {
    unsigned* bar; unsigned x;
    volatile LAS unsigned* st;
};

__device__ __forceinline__ XcdBarrier xcd_barrier_post(unsigned* bar, volatile LAS unsigned* st) {
    XcdBarrier b; b.bar = bar; b.x = xb_xcc_id(); b.st = st;
    if (threadIdx.x == 0) (void)xb_add(&bar[XB_XCNT(b.x)], 1u);
    return b;
}
__device__ __forceinline__ void xcd_barrier_complete(unsigned* bar, unsigned x, unsigned& nloc, unsigned& nx) {
    const unsigned G = gridDim.x * gridDim.y * gridDim.z;
    unsigned sum, cnt, mine, sp = 0u;
    for (;;) {
        sum = 0u; cnt = 0u; mine = 0u;
#pragma unroll
        for (unsigned j = 0; j < 16; ++j) { const unsigned c = xb_ld(&bar[XB_XCNT(j)]); sum += c; cnt += (c > 0u) ? 1u : 0u; mine = (j == x) ? c : mine; }
        if (sum == G) break;
        __builtin_amdgcn_s_sleep(1);
        if ((++sp & 255u) == 0u) { if (xb_ld(&bar[XB_TMO])) break; if (sp > XB_SPIN_CAP) { atomicAdd(&bar[XB_TMO], 1u); break; } }
    }
    nloc = mine > 0u ? mine : 1u; nx = cnt > 0u ? cnt : 1u;
}

__device__ __forceinline__ void xcd_barrier(const XcdBarrier& b) {
    asm volatile("s_waitcnt vmcnt(0)" ::: "memory");
    __syncthreads();
    if (threadIdx.x == 0) {
        unsigned* bar = b.bar;
        __builtin_amdgcn_s_waitcnt(0);
        unsigned nloc = b.st[0], nx = b.st[1];
        if (nloc == 0u) { xcd_barrier_complete(bar, b.x, nloc, nx); b.st[0] = nloc; b.st[1] = nx; }
        const unsigned old = xb_add(&bar[XB_XSUB(b.x)], 1u);
        const unsigned gen = old / nloc;
        if (old + 1u == (gen + 1u) * nloc) {
            __builtin_amdgcn_fence(__ATOMIC_RELEASE, "agent");
            asm volatile("s_waitcnt vmcnt(0)" ::: "memory");
            const unsigned og = xb_add(&bar[XB_TOP], 1u);
            const unsigned tg = og / nx;
            if (og + 1u == (tg + 1u) * nx) xb_add(&bar[XB_TOPGEN], 1u);
            else XB_SPIN(xb_ld(&bar[XB_TOPGEN]) == tg, bar);
            __builtin_amdgcn_fence(__ATOMIC_ACQUIRE, "agent");
            xb_add(&bar[XB_XGEN(b.x)], 1u);
            asm volatile("s_waitcnt vmcnt(0)" ::: "memory");
        } else {
            XB_SPIN(xb_ld(&bar[XB_XGEN(b.x)]) == gen, bar);
            __builtin_amdgcn_fence(__ATOMIC_ACQUIRE, "agent");
            asm volatile("s_waitcnt vmcnt(0)" ::: "memory");
        }
    }
    __syncthreads();
}
__device__ __forceinline__ void gsync(cg::grid_group& grid) {
    asm volatile("s_waitcnt vmcnt(0) lgkmcnt(0)" ::: "memory");
    grid.sync();
    __builtin_amdgcn_fence(__ATOMIC_ACQUIRE, "agent");
    asm volatile("s_waitcnt vmcnt(0)" ::: "memory");
}
template <int l>
__device__ __forceinline__ void layer_body(int wv, const Params& p, LAS unsigned char* lds, const XcdBarrier& xbar) {
    const int G = gridDim.x, bid = blockIdx.x;
    u64* RS = (u64*)(p.ws + WS_RS); const float* LBS = (const float*)(p.ws + WS_LBS);
    bf16_t* WT = (bf16_t*)(p.ws + WS_WT);
    bf16_t* XB0p = (bf16_t*)(p.ws + WS_XB0); bf16_t* XB1p = (bf16_t*)(p.ws + WS_XB1);
    bf16_t* PB = (bf16_t*)(p.ws + WS_PB); bf16_t* Z = (bf16_t*)(p.ws + WS_Z); float* LF = (float*)(p.ws + WS_LF); bf16_t* MIX = (bf16_t*)(p.ws + WS_MIX);
    bf16_t* ACT = (bf16_t*)(p.ws + WS_ACT); bf16_t* SIDE = (bf16_t*)(p.ws + WS_SIDE);
    float* X = p.out + O_Y;
        const bf16_t* wl = WT + (size_t)l * WT_LAYER;
        bf16_t* xa = (l & 1) ? XB1p : XB0p; bf16_t* xb = (l & 1) ? XB0p : XB1p;
        pg8::StaticOrder S;
        if (PHM & 2) {
            pg8::Gemm g{xa, wl + WT_IN, DM, DM, MPR / 256, DIN / 256}; S.init(g.nM, g.nN, G, bid);
            EpiIn E{Z, LF, RS + (size_t)(3 * l) * MP, LBS + l * 1024};
            pg8::gemm_phase<EpiIn>(wv, lds, g, S, E);
            SkIn E2{Z, LF, RS + (size_t)(3 * l) * MP, LBS + l * 1024};
            { const int rem = (g.nM * g.nN) % G; const int nslack = (rem != 0 && (G - rem) * 4 >= DIN / 32) ? G - rem : 0;
              skinny_phase<2, SkIn>(wv, lds, xa + (size_t)MPR * DM, DM, wl + WT_IN, DM, DIN / 32, E2, nslack); }
        }
        xcd_barrier(xbar);
        if (PHM & 4) { phase_mixers(wv, p, (unsigned char*)xb, l, lds); xcd_barrier(xbar); phase_hgrn2(wv, p, (const unsigned char*)xb, l); xcd_barrier(xbar); phase_hgrn3(wv, p, l, lds); }
        xcd_barrier(xbar);
        if (PHM & 8) {
            pg8::Gemm g{MIX, wl + WT_OUT, DM, DM, MPR / 256, DM / 256}; S.init(g.nM, g.nN, G, bid);
            EpiRes E{xa, xb, RS + (size_t)(3 * l + 1) * MP};
            pg8::gemm_phase<EpiRes>(wv, lds, g, S, E);
            SkRes E2{xa, xb, RS + (size_t)(3 * l + 1) * MP};
            skinny_phase<1, SkRes>(wv, lds, MIX + (size_t)MPR * DM, DM, wl + WT_OUT, DM, DM / 16, E2);
        }
        xcd_barrier(xbar);
        if (PHM & 16) {
            pg8::Gemm g{xb, wl + WT_UP, DM, DM, MPR / 256, DFF2 / 256}; S.init(g.nM, g.nN, G, bid);
            EpiUp E{ACT, SIDE, RS + (size_t)(3 * l + 1) * MP, p.in[22] + (size_t)l * 3 * DFF2, p.in[23] + (size_t)l * DFF2,
                    p.out + O_CP + (size_t)l * 8 * 2 * DFF2, p.out + O_CS + (size_t)l * NSAMP * 2 * DFF2};
            pg8::gemm_phase<EpiUp>(wv, lds, g, S, E);
            SkUp E2{RS + (size_t)(3 * l + 1) * MP, p.out + O_CS + (size_t)l * NSAMP * 2 * DFF2};
            skinny_phase<4, SkUp>(wv, lds, xb + (size_t)MPR * DM, DM, wl + WT_UP, DM, DFF2 / 64, E2);
        }
        xcd_barrier(xbar);
        if (PHM & 32) {
            phase_fixup(wv, p, l);
            pg8::Gemm g{PB + (size_t)l * MP * PLE, wl + WT_PROJ, PLE, PLE, MPR / 256, DM / 256}; S.init(g.nM, g.nN, G, bid);
            EpiProj E{(bf16_t*)(p.ws + WS_LF)};
            pg8::gemm_phase<EpiProj>(wv, lds, g, S, E);
            SkProj E2{(bf16_t*)(p.ws + WS_LF)};
            skinny_phase<1, SkProj>(wv, lds, PB + ((size_t)l * MP + MPR) * PLE, PLE, wl + WT_PROJ, PLE, DM / 16, E2);
        }
        xcd_barrier(xbar);
        if (PHM & 64) {
            pg8::Gemm g{ACT, wl + WT_DOWN, DFF, DFF, MPR / 256, DM / 256}; S.init(g.nM, g.nN, G, bid);
            EpiRes E{xb, xa, RS + (size_t)(3 * l + 2) * MP};
            pg8::gemm_phase<EpiRes>(wv, lds, g, S, E);
            SkRes E2{xb, xa, RS + (size_t)(3 * l + 2) * MP};
            skinny_phase<1, SkRes>(wv, lds, ACT + (size_t)MPR * DFF, DFF, wl + WT_DOWN, DFF, DM / 16, E2);
        }
        xcd_barrier(xbar);
        if (PHM & 128) {
            pg8::Gemm g{xa, wl + WT_GATE, DM, DM, MPR / 256, DM / 256}; S.init(g.nM, g.nN, G, bid);
            EpiGate E{xa, (const bf16_t*)(p.ws + WS_LF), xb, l == 1 ? X : nullptr, RS + (size_t)(3 * l + 2) * MP, RS + (size_t)(3 * l + 3) * MP};
            pg8::gemm_phase<EpiGate>(wv, lds, g, S, E);
            SkGate E2{xa, (const bf16_t*)(p.ws + WS_LF), xb, l == 1 ? X : nullptr, RS + (size_t)(3 * l + 2) * MP, RS + (size_t)(3 * l + 3) * MP};
            skinny_phase<1, SkGate>(wv, lds, xa + (size_t)MPR * DM, DM, wl + WT_GATE, DM, DM / 16, E2);
        }
}
__global__ void __launch_bounds__(512, 2) mega_fwd(Params p) {
    extern __shared__ __attribute__((aligned(16))) unsigned char lds_raw[];
    LAS unsigned char* lds = (LAS unsigned char*)lds_raw;
    cg::grid_group grid = cg::this_grid();
    const int wv = __builtin_amdgcn_readfirstlane(threadIdx.x >> 6);
    volatile LAS unsigned* st = (volatile LAS unsigned*)(lds + LDS_ST_OFF);
    if (threadIdx.x < 4) st[threadIdx.x] = 0u;
    __syncthreads();
    const XcdBarrier xbar = xcd_barrier_post((unsigned*)(p.ws + WS_BAR), st);
    if (PHM & 1) phase_prep(wv, p, lds);
    if (gridDim.y == 0x7fff) gsync(grid);
    xcd_barrier(xbar);
#ifndef NLAYER
#define NLAYER 2
#endif
    layer_body<0>(wv, p, lds, xbar);
    if (NLAYER > 1) { xcd_barrier(xbar);
    layer_body<1>(wv, p, lds, xbar); }
}

extern "C" void kernel_launch(void* const* d_in, const int* in_sizes, int n_in, void* d_out, int out_size, void* d_ws, size_t ws_size, hipStream_t stream) {
    static int grid = 0;
    if (grid == 0) {
        if (n_in != 28 || ws_size < WS_END) { fprintf(stderr, "kernel_launch: need 28 inputs and >= %zu bytes of workspace (got %d, %zu)\n", (size_t)WS_END, n_in, ws_size); grid = -1; return; }
        int dev = 0, cus = 0, per_cu = 0;
        hipGetDevice(&dev); hipDeviceGetAttribute(&cus, hipDeviceAttributeMultiprocessorCount, dev);
        if (hipFuncSetAttribute((const void*)mega_fwd, hipFuncAttributeMaxDynamicSharedMemorySize, LDS_BYTES) != hipSuccess) { fprintf(stderr, "kernel_launch: hipFuncSetAttribute failed\n"); grid = -1; return; }
        if (hipOccupancyMaxActiveBlocksPerMultiprocessor(&per_cu, (const void*)mega_fwd, 512, LDS_BYTES) != hipSuccess || per_cu < 1) { fprintf(stderr, "kernel_launch: occupancy query says %d\n", per_cu); per_cu = 1; }
        (void)hipGetLastError();
        grid = cus * 1;
    }
    if (grid < 0) return;
    (void)hipMemsetAsync((char*)d_ws + WS_BAR, 0, XCD_BAR_WORDS * 4, stream);
    Params p{};
    for (int i = 0; i < 28; ++i) p.in[i] = (const float*)d_in[i];
    p.out = (float*)d_out; p.ws = (unsigned char*)d_ws;
    void* args[] = {&p};
    hipError_t e = hipLaunchCooperativeKernel((const void*)mega_fwd, dim3(grid), dim3(512), args, LDS_BYTES, stream);
    if (e != hipSuccess) fprintf(stderr, "cooperative launch failed: %s (grid %d)\n", hipGetErrorString(e), grid);
}
```
